# Optimizing an MI355X kernel written in HIP

```python
import jax, jax.numpy as jnp
from jax import lax
import numpy as np

D_MODEL = 1024
BATCH = 2
SEQ = 16384
DEPTH = 4

GRID_W = 64
CTX_LEN = 256
D_CONV = D_MODEL // 2
CONV_K = 3
D_SSM = D_MODEL // 2
SSM_GROUP = 16
N_GROUPS = D_SSM // SSM_GROUP
STATE = 64
N_DIR = 2
D_FF = -(-8 * D_MODEL // (3 * 256)) * 256
D_IN_PROJ = 3 * D_CONV + D_SSM + 2 * D_MODEL
SPLITS = [D_CONV, 2 * D_CONV, 3 * D_CONV, 3 * D_CONV + D_SSM, 3 * D_CONV + D_SSM + D_MODEL]
U_LO, U_HI = 3 * D_CONV, 3 * D_CONV + D_SSM
RMS_EPS = 1e-6
DT_MIN, DT_MAX = 1e-3, 1e-1

kernel_name = "hybrid_shortconv_s5_adaln_prefix_block"


def rmsnorm(x, g):
    xf = x.astype(jnp.float32)
    y = xf * lax.rsqrt(jnp.mean(xf * xf, axis=-1, keepdims=True) + RMS_EPS)
    return (y * g.astype(jnp.float32)).astype(x.dtype)


def modulate(h, shift, scale):
    return h * (1 + scale) + shift


def conv_centered(z, w):
    pad = CONV_K // 2
    n = z.shape[-2]
    zp = jnp.pad(z, [(0, 0)] * (z.ndim - 2) + [(pad, pad), (0, 0)])
    return sum(lax.slice_in_dim(zp, k, k + n, axis=z.ndim - 2) * w[k] for k in range(CONV_K))


def zoh(lam_re, lam_im, log_dt, b_re, b_im):
    lam_re = lam_re.astype(jnp.float32)
    lam_im = lam_im.astype(jnp.float32)
    dt = jnp.exp(log_dt.astype(jnp.float32))[:, None]
    mag = jnp.exp(lam_re * dt)
    a_re = mag * jnp.cos(lam_im * dt)
    a_im = mag * jnp.sin(lam_im * dt)
    nr, ni = a_re - 1.0, a_im
    den = lam_re * lam_re + lam_im * lam_im
    f_re = (nr * lam_re + ni * lam_im) / den
    f_im = (ni * lam_re - nr * lam_im) / den
    br, bi = b_re.astype(jnp.float32), b_im.astype(jnp.float32)
    bb_re = f_re[..., None] * br - f_im[..., None] * bi
    bb_im = f_re[..., None] * bi + f_im[..., None] * br
    return a_re, a_im, bb_re, bb_im


def _linrec_combine(e1, e2):
    a1r, a1i, b1r, b1i = e1
    a2r, a2i, b2r, b2i = e2
    return (a2r * a1r - a2i * a1i,
            a2r * a1i + a2i * a1r,
            a2r * b1r - a2i * b1i + b2r,
            a2r * b1i + a2i * b1r + b2i)


def ssm_states(u, lam_re, lam_im, log_dt, b_re, b_im, h0):
    bsz, n = u.shape[0], u.shape[1]
    ug = u.astype(jnp.float32).reshape(bsz, n, N_GROUPS, SSM_GROUP)
    states = []
    for d in range(N_DIR):
        reverse = d == 1
        a_re, a_im, bb_re, bb_im = zoh(lam_re[d], lam_im[d], log_dt[d], b_re[d], b_im[d])
        bu_re = jnp.einsum('bngh,gph->bngp', ug, bb_re)
        bu_im = jnp.einsum('bngh,gph->bngp', ug, bb_im)
        if h0 is not None:
            hr, hi = h0[d]
            first = n - 1 if reverse else 0
            bu_re = bu_re.at[:, first].add(a_re * hr - a_im * hi)
            bu_im = bu_im.at[:, first].add(a_re * hi + a_im * hr)
        ar = jnp.broadcast_to(a_re, bu_re.shape)
        ai = jnp.broadcast_to(a_im, bu_re.shape)
        _, _, s_re, s_im = lax.associative_scan(
            _linrec_combine, (ar, ai, bu_re, bu_im), reverse=reverse, axis=1)
        states.append((s_re, s_im))
    return states


def final_states(states):
    (fr, fi), (br, bi) = states
    return [(fr[:, -1], fi[:, -1]), (br[:, 0], bi[:, 0])]


def ssm_readout(states, u, c_re, c_im, d_skip):
    bsz, n = u.shape[0], u.shape[1]
    y = u.astype(jnp.float32) * d_skip.astype(jnp.float32)
    for d, (s_re, s_im) in enumerate(states):
        yd = (jnp.einsum('bngp,ghp->bngh', s_re, c_re[d].astype(jnp.float32))
              - jnp.einsum('bngp,ghp->bngh', s_im, c_im[d].astype(jnp.float32)))
        y = y + yd.reshape(bsz, n, D_SSM)
    return y.astype(u.dtype)


def mixer(h, lp, rows, h0):
    z = h @ lp['w_in'] + lp['b_in']
    g_b, g_c, x_in, u, gate_a, gate_b = jnp.split(z, SPLITS, axis=-1)
    v = g_c * x_in
    if rows is None:
        v = conv_centered(v, lp['conv_w'])
    else:
        bsz, n, ch = v.shape
        v = conv_centered(v.reshape(bsz, rows, GRID_W, ch), lp['conv_w']).reshape(bsz, n, ch)
    y_a = (g_b * v) @ lp['w_out_a']
    states = ssm_states(u, lp['lam_re'], lp['lam_im'], lp['log_dt'], lp['b_re'], lp['b_im'], h0)
    s = jax.nn.gelu(ssm_readout(states, u, lp['c_re'], lp['c_im'], lp['d_skip']))
    glu_v, glu_g = jnp.split(s @ lp['w_glu'] + lp['b_glu'], 2, axis=-1)
    y_b = glu_v * jax.nn.sigmoid(glu_g)
    merged = jax.nn.sigmoid(gate_a) * y_a + jax.nn.sigmoid(gate_b) * y_b
    return merged @ lp['w_o'], states


def swiglu(h, w_in, w_out):
    g, u = jnp.split(h @ w_in, 2, axis=-1)
    return (jax.nn.silu(g) * u) @ w_out


def setup_inputs(seed: int = 0) -> dict:
    key = jax.random.key(seed)
    ks = jax.random.split(key, 32)
    f32 = jnp.float32
    nrm = lambda k, shape, s: jax.random.normal(k, shape, f32) * s
    n_idx = jnp.arange(STATE, dtype=f32)
    lam_re = -0.5 + nrm(ks[10], (DEPTH, N_DIR, N_GROUPS, STATE), 0.01)
    lam_im = jnp.pi * n_idx + nrm(ks[11], (DEPTH, N_DIR, N_GROUPS, STATE), 0.01)
    log_dt = jax.random.uniform(ks[12], (DEPTH, N_DIR, N_GROUPS), f32,
                                np.log(DT_MIN).astype(np.float32), np.log(DT_MAX).astype(np.float32))
    return {
        "x": nrm(ks[0], (BATCH, SEQ, D_MODEL), 1.0),
        "c": nrm(ks[1], (BATCH, D_MODEL), 1.0),
        "ctx": nrm(ks[2], (BATCH, CTX_LEN, D_MODEL), 1.0),
        "c_ctx": nrm(ks[3], (D_MODEL,), 1.0),
        "w_mod": nrm(ks[4], (DEPTH, D_MODEL, 6 * D_MODEL), 0.5 * D_MODEL ** -0.5),
        "b_mod": nrm(ks[5], (DEPTH, 6 * D_MODEL), 0.01),
        "norm1_g": 1.0 + nrm(ks[6], (DEPTH, D_MODEL), 0.02),
        "norm2_g": 1.0 + nrm(ks[7], (DEPTH, D_MODEL), 0.02),
        "w_in": nrm(ks[8], (DEPTH, D_MODEL, D_IN_PROJ), D_MODEL ** -0.5),
        "b_in": nrm(ks[9], (DEPTH, D_IN_PROJ), 0.01),
        "conv_w": nrm(ks[13], (DEPTH, CONV_K, D_CONV), CONV_K ** -0.5),
        "w_out_a": nrm(ks[14], (DEPTH, D_CONV, D_MODEL), D_CONV ** -0.5),
        "lam_re": lam_re,
        "lam_im": lam_im,
        "log_dt": log_dt,
        "b_re": nrm(ks[15], (DEPTH, N_DIR, N_GROUPS, STATE, SSM_GROUP), (2 * SSM_GROUP) ** -0.5),
        "b_im": nrm(ks[16], (DEPTH, N_DIR, N_GROUPS, STATE, SSM_GROUP), (2 * SSM_GROUP) ** -0.5),
        "c_re": nrm(ks[17], (DEPTH, N_DIR, N_GROUPS, SSM_GROUP, STATE), (2 * STATE) ** -0.5),
        "c_im": nrm(ks[18], (DEPTH, N_DIR, N_GROUPS, SSM_GROUP, STATE), (2 * STATE) ** -0.5),
        "d_skip": nrm(ks[19], (DEPTH, D_SSM), 1.0),
        "w_glu": nrm(ks[20], (DEPTH, D_SSM, 2 * D_MODEL), D_SSM ** -0.5),
        "b_glu": nrm(ks[21], (DEPTH, 2 * D_MODEL), 0.01),
        "w_o": nrm(ks[22], (DEPTH, D_MODEL, D_MODEL), D_MODEL ** -0.5),
        "w_ff_in": nrm(ks[23], (DEPTH, D_MODEL, 2 * D_FF), D_MODEL ** -0.5),
        "w_ff_out": nrm(ks[24], (DEPTH, D_FF, D_MODEL), D_FF ** -0.5),
        "final_g": 1.0 + nrm(ks[25], (D_MODEL,), 0.02),
    }


def reference(x, c, ctx, c_ctx, w_mod, b_mod, norm1_g, norm2_g, w_in, b_in, conv_w, w_out_a,
              lam_re, lam_im, log_dt, b_re, b_im, c_re, c_im, d_skip, w_glu, b_glu, w_o,
              w_ff_in, w_ff_out, final_g):
    rows = x.shape[1] // GRID_W
    silu_c = jax.nn.silu(c)
    silu_cc = jax.nn.silu(c_ctx)
    for l in range(DEPTH):
        last = l == DEPTH - 1
        lp = {'w_in': w_in[l], 'b_in': b_in[l], 'conv_w': conv_w[l], 'w_out_a': w_out_a[l],
              'lam_re': lam_re[l], 'lam_im': lam_im[l], 'log_dt': log_dt[l],
              'b_re': b_re[l], 'b_im': b_im[l], 'c_re': c_re[l], 'c_im': c_im[l],
              'd_skip': d_skip[l], 'w_glu': w_glu[l], 'b_glu': b_glu[l], 'w_o': w_o[l]}
        sh1, sc1, g1, sh2, sc2, g2 = [m[:, None, :] for m in
                                      jnp.split(silu_c @ w_mod[l] + b_mod[l], 6, axis=-1)]
        n_ctx_mod = 2 if last else 6
        modc = jnp.split(silu_cc @ w_mod[l][:, :n_ctx_mod * D_MODEL]
                         + b_mod[l][:n_ctx_mod * D_MODEL], n_ctx_mod, axis=-1)
        hc = modulate(rmsnorm(ctx, norm1_g[l]), modc[0], modc[1])
        if last:
            u_ctx = hc @ w_in[l][:, U_LO:U_HI] + b_in[l][U_LO:U_HI]
            ctx_states = ssm_states(u_ctx, lp['lam_re'], lp['lam_im'], lp['log_dt'],
                                    lp['b_re'], lp['b_im'], None)
        else:
            out_c, ctx_states = mixer(hc, lp, None, None)
        h0 = final_states(ctx_states)
        h = modulate(rmsnorm(x, norm1_g[l]), sh1, sc1)
        out, _ = mixer(h, lp, rows, h0)
        x = x + g1 * out
        x = x + g2 * swiglu(modulate(rmsnorm(x, norm2_g[l]), sh2, sc2), w_ff_in[l], w_ff_out[l])
        if not last:
            ctx = ctx + modc[2] * out_c
            ctx = ctx + modc[5] * swiglu(modulate(rmsnorm(ctx, norm2_g[l]), modc[3], modc[4]),
                                         w_ff_in[l], w_ff_out[l])
    return rmsnorm(x, final_g)
```

```cpp
#include <hip/hip_runtime.h>
#include <hip/hip_cooperative_groups.h>
#include <cstdio>
#include <cstdint>
namespace cg = cooperative_groups;

#ifndef ONLY_SP
#define ONLY_SP -1
#endif
#ifndef MK_COOP
#define MK_COOP 0
#endif

#define LAS __attribute__((address_space(3)))
typedef unsigned short bf16_t;
typedef short bf16x8 __attribute__((ext_vector_type(8)));
typedef float f32x4 __attribute__((ext_vector_type(4)));
typedef unsigned u32x4 __attribute__((ext_vector_type(4)));

constexpr int D = 1024, SEQ = 16384, NLAT = 32768, CTXL = 256, NCTX = 512, TR = NLAT + NCTX  ;
constexpr int DEPTH = 4, DC = 512, DS = 512, NG = 32, NP = 64, DFF = 2816, DIN = 4096;
constexpr int NCH = TR / 64  , NCHP = 768, UROWS = NCHP * 64;
constexpr float RMS_EPS = 1e-6f;

constexpr size_t al(size_t x) { return (x + 4095) & ~(size_t)4095; }
constexpr size_t WS_ROWSS = 0;
constexpr size_t WS_MOD = al(WS_ROWSS + (size_t)TR * 16 * 4);
constexpr size_t WS_GSV = al(WS_MOD + (size_t)4 * 3 * 6144 * 4);
constexpr size_t WS_CIN = al(WS_GSV + (size_t)4 * 4 * 3 * 1024 * 4);
constexpr size_t WS_CFF = al(WS_CIN + (size_t)3 * 4096 * 4);
constexpr size_t WS_APOW = al(WS_CFF + (size_t)3 * 5632 * 4);
constexpr size_t WS_BBAR = al(WS_APOW + (size_t)4 * 2 * 32 * 65 * 64 * 2 * 4);
constexpr size_t WS_KC = al(WS_BBAR + (size_t)4 * 2 * 32 * 64 * 16 * 2 * 4);
constexpr size_t WS_WG = al(WS_KC + (size_t)32 * 127 * 256 * 2 + 8192);
constexpr size_t WS_MG = al(WS_WG + (size_t)32 * 256 * 1024 * 2);
constexpr size_t WS_SLOC = al(WS_MG + (size_t)32 * 1024 * 256 * 2);
constexpr size_t WS_SIN = al(WS_SLOC + (size_t)32 * NCHP * 256 * 4);
constexpr size_t WS_CTXX = al(WS_SIN + (size_t)32 * NCHP * 256 * 2);
constexpr size_t WS_WT = al(WS_CTXX + (size_t)NCTX * D * 4);
constexpr size_t WT_IN = 0, WT_OUTA = WT_IN + (size_t)DIN * D * 2, WT_GLU = WT_OUTA + (size_t)D * DC * 2, WT_O = WT_GLU + (size_t)2048 * DS * 2,
                 WT_FFIN = WT_O + (size_t)D * D * 2, WT_FFOUT = WT_FFIN + (size_t)2 * DFF * D * 2, WT_END = WT_FFOUT + (size_t)D * DFF * 2;
constexpr size_t WS_XS = al(WS_WT + WT_END);
constexpr size_t WS_YB = al(WS_XS + (size_t)TR * D * 2);
constexpr size_t WS_GB = al(WS_YB + (size_t)TR * D * 2);
constexpr size_t WS_V = al(WS_GB + (size_t)TR * DC * 2);
constexpr size_t WS_U = al(WS_V + (size_t)TR * DC * 2);
constexpr size_t WS_S = al(WS_U + (size_t)NG * UROWS * 16 * 2);
constexpr size_t WS_SGA = al(WS_S + (size_t)TR * DS * 2);
constexpr size_t WS_OVL_END = al(WS_SGA + (size_t)TR * D * 2);
constexpr size_t WS_HID = WS_GB;
static_assert(WS_HID + (size_t)TR * DFF * 2 <= WS_OVL_END, "hid overlay");
constexpr size_t WS_END = WS_OVL_END;
static_assert(WS_END <= (size_t)512 * 1024 * 1024, "workspace");

constexpr int LDS_BYTES = 147456;

__device__ __forceinline__ unsigned f2bf(float f) { unsigned u = __builtin_bit_cast(unsigned, f); return (u + 0x7fffu + ((u >> 16) & 1u)) >> 16; }
__device__ __forceinline__ unsigned pk2(float lo, float hi) { return f2bf(lo) | (f2bf(hi) << 16); }
__device__ __forceinline__ float bflo(unsigned w) { return __builtin_bit_cast(float, w << 16); }
__device__ __forceinline__ float bfhi(unsigned w) { return __builtin_bit_cast(float, w & 0xffff0000u); }
__device__ __forceinline__ float sigm(float x) { return __builtin_amdgcn_rcpf(1.0f + __expf(-x)); }
__device__ __forceinline__ float wave_sum(float v) {
#pragma unroll
    for (int o = 1; o < 64; o <<= 1) v += __shfl_xor(v, o);
    return v;
}
__device__ __forceinline__ void sincos_cw(float x, float& s, float& c) {
    const float q = rintf(x * 0.63661977236758134f);
    float r = fmaf(-q, 1.5703125f, x);
    r = fmaf(-q, 4.837512969970703125e-4f, r);
    r = fmaf(-q, 7.54978995489188e-8f, r);
    const float r2 = r * r;
    float sp = fmaf(r2, 2.7557319e-6f, -1.9841270e-4f); sp = fmaf(sp, r2, 8.3333333e-3f); sp = fmaf(sp, r2, -1.6666667e-1f); sp = fmaf(sp * r2, r, r);
    float cp = fmaf(r2, -2.7557319e-7f, 2.4801587e-5f); cp = fmaf(cp, r2, -1.3888889e-3f); cp = fmaf(cp, r2, 4.1666667e-2f); cp = fmaf(cp, r2, -0.5f); cp = fmaf(cp, r2, 1.0f);
    const int qi = (int)q & 3;
    const float ss = (qi & 1) ? cp : sp, cc = (qi & 1) ? sp : cp;
    s = (qi & 2) ? -ss : ss; c = ((qi + 1) & 2) ? -cc : cc;
}

namespace pg8 {
constexpr int BM = 256, BK = 64, HALF = 128, HTB = HALF * BK * 2, STAGE_BYTES = 8 * HTB, NXCD = 8, WGM = 8;
__host__ __device__ __forceinline__ int lds_byte(int r, int c) { const int st = (r >> 4) * 2 + (c >> 5), rr = r & 15, cc = c & 31, ob = rr * 64 + cc * 2; return st * 1024 + (ob ^ (((ob >> 9) & 1) << 5)); }
__host__ __device__ __forceinline__ void stage_rc(int b, int& R, int& C) { const int st = b / 1024, sb = b % 1024, swz = sb ^ (((sb >> 9) & 1) << 5); R = (st >> 1) * 16 + swz / 64; C = (st & 1) * 32 + (swz % 64) / 2; }
__host__ __device__ __forceinline__ int perm32(int rho) { const int n = rho >> 4, i = rho & 15; return 8 * (i >> 2) + 4 * n + (i & 3); }

struct Unit { int pm, pn, g; };
struct Seg { const char* A; const char* B; int tA, tB, gA, gB, hA, hB, kA, kB; };

struct Order {
    int nM, nN, nwg, G, c, grouped;
    __device__ void init(int nM_, int nN_, int nG_, int G_, int c_) { nM = nM_; nN = nN_; grouped = nG_ > 1; nwg = nM * nN * nG_; G = G_; c = c_; }
    __device__ bool next(int i, Unit& u) const {
        const long L = (long)i * G + c; if (L >= nwg) return false;
        if (grouped) { const int per = nM * nN; u.g = (int)L / per; const int r = (int)L % per; u.pm = r % nM; u.pn = r / nM; return true; }
        int wgid = (int)L; { const int q = nwg / NXCD, r = nwg % NXCD, xcd = wgid % NXCD, off = wgid / NXCD; wgid = (xcd < r ? xcd * (q + 1) : r * (q + 1) + (xcd - r) * q) + off; }
        const int nig = WGM * nN, gid = wgid / nig, fm = gid * WGM, gsz = (nM - fm) < WGM ? (nM - fm) : WGM;
        u.pm = fm + ((wgid % nig) % gsz); u.pn = (wgid % nig) / gsz; u.g = 0; return true;
    }
};

struct Voff { unsigned a0, a1, b0, b1; };
__device__ __forceinline__ Voff voff_plain(int tid, int ldaB, int ldbB) {
    Voff v; int R, C;
    stage_rc(tid * 16, R, C); { const int Rb = (R & ~31) + perm32(R & 31); v.a0 = (unsigned)(R * ldaB + C * 2); v.b0 = (unsigned)(Rb * ldbB + C * 2); }
    stage_rc(tid * 16 + 8192, R, C); { const int Rb = (R & ~31) + perm32(R & 31); v.a1 = (unsigned)(R * ldaB + C * 2); v.b1 = (unsigned)(Rb * ldbB + C * 2); }
    return v;
}

#define EPI_ARGS const f32x4 (&acc)[2][2][4][2], const pg8::Unit& u, int wr, int wc, int fr, int fq

template <class Epi, bool TWOSEG>
__device__ __forceinline__ void gemm_phase(LAS unsigned char* lds, const Seg s0, const Seg s1, const int nt0, const int nt_in, const Voff v0_in, const Voff v1_in, const Order& S, const Epi& E, const int tid) {
    int nt = nt_in; asm volatile("" : "+s"(nt));
    const int wid = __builtin_amdgcn_readfirstlane(tid >> 6), lane = tid & 63, wr = wid >> 2, wc = wid & 3, fr = lane & 15, fq = lane >> 4;
    const unsigned ldsw = (unsigned)wid * 1024u;
    const int aoff = lds_byte(wr * 64 + fr, fq * 8), boff = lds_byte(wc * 32 + fr, fq * 8);
#define PG8_SA(b, h) (((b) * 2 + (h)) * HTB)
#define PG8_SB(b, h) ((4 + (b) * 2 + (h)) * HTB)
#define PG8_SEG1(t) (TWOSEG && (t) >= nt0)
#define PG8_UA(u, t) (PG8_SEG1(t) ? (s1.A + (long long)((u).g * s1.gA + (u).pm * s1.tA + ((t) - nt0) * s1.kA)) : (s0.A + (long long)((u).g * s0.gA + (u).pm * s0.tA + (t) * s0.kA)))
#define PG8_UB(u, t) (PG8_SEG1(t) ? (s1.B + (long long)((u).g * s1.gB + (u).pn * s1.tB + ((t) - nt0) * s1.kB)) : (s0.B + (long long)((u).g * s0.gB + (u).pn * s0.tB + (t) * s0.kB)))
#define PG8_HA(t) (PG8_SEG1(t) ? s1.hA : s0.hA)
#define PG8_HB(t) (PG8_SEG1(t) ? s1.hB : s0.hB)
#define PG8_STG(bufoff, gptr, o0, o1) do { \
        __builtin_amdgcn_global_load_lds((const unsigned*)((gptr) + (o0)), (LAS unsigned*)(lds + (bufoff) + ldsw), 16, 0, 0); \
        __builtin_amdgcn_global_load_lds((const unsigned*)((gptr) + (o1)), (LAS unsigned*)(lds + (bufoff) + ldsw + 8192), 16, 0, 0); } while (0)
#define PG8_STG_A(bufoff, gptr, t) do { const bool s_ = PG8_SEG1(t); PG8_STG(bufoff, gptr, s_ ? v1.a0 : v0.a0, s_ ? v1.a1 : v0.a1); } while (0)
#define PG8_STG_B(bufoff, gptr, t) do { const bool s_ = PG8_SEG1(t); PG8_STG(bufoff, gptr, s_ ? v1.b0 : v0.b0, s_ ? v1.b1 : v0.b1); } while (0)
#define PG8_LDA(dst, b, h) do { _Pragma("unroll") for (int m = 0; m < 4; ++m) _Pragma("unroll") for (int k = 0; k < 2; ++k) dst[m][k] = *(const LAS bf16x8*)(lds + PG8_SA(b, h) + aoff + m * 2048 + k * 1024); } while (0)
#define PG8_LDB(dst, b, h) do { _Pragma("unroll") for (int n = 0; n < 2; ++n) _Pragma("unroll") for (int k = 0; k < 2; ++k) dst[n][k] = *(const LAS bf16x8*)(lds + PG8_SB(b, h) + boff + n * 2048 + k * 1024); } while (0)
#define PG8_MMA(ai, bj, At, Bt) do { __builtin_amdgcn_s_setprio(1); _Pragma("unroll") for (int m = 0; m < 4; ++m) _Pragma("unroll") for (int n = 0; n < 2; ++n) _Pragma("unroll") for (int k = 0; k < 2; ++k) \
        acc[ai][bj][m][n] = __builtin_amdgcn_mfma_f32_16x16x32_bf16(Bt[n][k], At[m][k], acc[ai][bj][m][n], 0, 0, 0); __builtin_amdgcn_s_setprio(0); } while (0)
#define PG8_WAIT_V(n) asm volatile("s_waitcnt vmcnt(" #n ")" ::: "memory")
#define PG8_WAIT_L(n) asm volatile("s_waitcnt lgkmcnt(" #n ")" ::: "memory")
#define PG8_BAR __builtin_amdgcn_s_barrier()
#define PG8_SCHED __builtin_amdgcn_sched_barrier(0)
    Unit cur, nxt; int ui = 0;
    if (!S.next(0, cur)) return;
    f32x4 acc[2][2][4][2];
#pragma unroll
    for (int a = 0; a < 2; ++a)
#pragma unroll
        for (int b = 0; b < 2; ++b)
#pragma unroll
            for (int m = 0; m < 4; ++m)
#pragma unroll
                for (int n = 0; n < 2; ++n) acc[a][b][m][n] = (f32x4){0.f, 0.f, 0.f, 0.f};
    bf16x8 At[4][2], B0[2][2], B1[2][2];
    Voff v0 = v0_in, v1 = v1_in;
    asm volatile("" : "+v"(v0.a0), "+v"(v0.a1), "+v"(v0.b0), "+v"(v0.b1));
    if (TWOSEG) asm volatile("" : "+v"(v1.a0), "+v"(v1.a1), "+v"(v1.b0), "+v"(v1.b1));
    {
        const char* cA0 = PG8_UA(cur, 0); const char* cB0 = PG8_UB(cur, 0); const char* cA1 = PG8_UA(cur, 1); const char* cB1 = PG8_UB(cur, 1);
        PG8_STG_B(PG8_SB(0, 0), cB0, 0); PG8_STG_A(PG8_SA(0, 0), cA0, 0); PG8_STG_B(PG8_SB(0, 1), cB0 + PG8_HB(0), 0); PG8_STG_A(PG8_SA(0, 1), cA0 + PG8_HA(0), 0);
        if (wr == 1) PG8_BAR;
        PG8_WAIT_V(4); PG8_BAR;
        PG8_STG_B(PG8_SB(1, 0), cB1, 1); PG8_STG_A(PG8_SA(1, 0), cA1, 1); PG8_STG_B(PG8_SB(1, 1), cB1 + PG8_HB(1), 1);
        PG8_WAIT_V(6); PG8_BAR;
    }
    for (;;) {
        const bool has_next = S.next(ui + 1, nxt);
        Unit nu; nu.pm = has_next ? nxt.pm : cur.pm; nu.pn = has_next ? nxt.pn : cur.pn; nu.g = has_next ? nxt.g : cur.g;
#pragma clang loop unroll(disable)
        for (int t = 0; t < nt; t += 2) {
            const bool last = (t == nt - 2);
            const int t1 = t + 1, t2 = last ? 0 : t + 2, t3 = t2 + 1;
            Unit u2; u2.pm = last ? nu.pm : cur.pm; u2.pn = last ? nu.pn : cur.pn; u2.g = last ? nu.g : cur.g;
            const char* a1 = PG8_UA(cur, t1);
            const char* a2 = PG8_UA(u2, t2); const char* b2 = PG8_UB(u2, t2);
            const char* a3 = PG8_UA(u2, t3); const char* b3 = PG8_UB(u2, t3);
            PG8_LDB(B0, 0, 0); PG8_SCHED; PG8_LDA(At, 0, 0); PG8_STG_A(PG8_SA(1, 1), a1 + PG8_HA(t1), t1);
            PG8_WAIT_L(8); PG8_BAR; PG8_WAIT_L(0); PG8_MMA(0, 0, At, B0); PG8_BAR; PG8_SCHED;
            PG8_LDB(B1, 0, 1); PG8_STG_B(PG8_SB(0, 0), b2, t2);
            PG8_BAR; PG8_WAIT_L(0); PG8_MMA(0, 1, At, B1); PG8_BAR;
            PG8_LDA(At, 0, 1); PG8_STG_A(PG8_SA(0, 0), a2, t2);
            PG8_BAR; PG8_WAIT_L(0); PG8_MMA(1, 0, At, B0); PG8_BAR; PG8_SCHED;
            PG8_STG_B(PG8_SB(0, 1), b2 + PG8_HB(t2), t2);
            PG8_WAIT_V(6); PG8_BAR; PG8_MMA(1, 1, At, B1); PG8_BAR;
            PG8_LDB(B0, 1, 0); PG8_SCHED; PG8_LDA(At, 1, 0); PG8_STG_A(PG8_SA(0, 1), a2 + PG8_HA(t2), t2);
            PG8_WAIT_L(8); PG8_BAR; PG8_WAIT_L(0); PG8_MMA(0, 0, At, B0); PG8_BAR; PG8_SCHED;
            PG8_LDB(B1, 1, 1); PG8_STG_B(PG8_SB(1, 0), b3, t3);
            PG8_BAR; PG8_WAIT_L(0); PG8_MMA(0, 1, At, B1); PG8_BAR;
            PG8_LDA(At, 1, 1); PG8_STG_A(PG8_SA(1, 0), a3, t3);
            PG8_BAR; PG8_WAIT_L(0); PG8_MMA(1, 0, At, B0); PG8_BAR; PG8_SCHED;
            PG8_STG_B(PG8_SB(1, 1), b3 + PG8_HB(t3), t3);
            PG8_WAIT_V(6); PG8_BAR; PG8_MMA(1, 1, At, B1); PG8_BAR;
        }
        E(acc, cur, wr, wc, fr, fq);
        if (!has_next) break;
#pragma unroll
        for (int a = 0; a < 2; ++a)
#pragma unroll
            for (int b = 0; b < 2; ++b)
#pragma unroll
                for (int m = 0; m < 4; ++m)
#pragma unroll
                    for (int n = 0; n < 2; ++n) acc[a][b][m][n] = (f32x4){0.f, 0.f, 0.f, 0.f};
        cur = nxt; ++ui;
    }
    PG8_WAIT_V(0);
    if (wr == 0) PG8_BAR;
    PG8_BAR;
#undef PG8_SA
#undef PG8_SB
#undef PG8_SEG1
#undef PG8_UA
#undef PG8_UB
#undef PG8_HA
#undef PG8_HB
#undef PG8_STG
#undef PG8_STG_A
#undef PG8_STG_B
#undef PG8_LDA
#undef PG8_LDB
#undef PG8_MMA
#undef PG8_WAIT_V
#undef PG8_WAIT_L
#undef PG8_BAR
#undef PG8_SCHED
}
}

struct Args { const float* in[26]; float* out; unsigned char* ws; int ph_lo, ph_hi, coop, pad; };

struct Ctx {
    const float* const* in; float* out; unsigned char* ws; LAS unsigned char* lds;
    int tid, lane, wave, G, bid;
};
#define WSP(T, off) ((T*)(C.ws + (off)))
__device__ __forceinline__ int sid_of_pm(int pm) { return pm < 64 ? 0 : (pm < 128 ? 1 : 2); }
__device__ __forceinline__ int sid_of_row(int r) { return r < SEQ ? 0 : (r < NLAT ? 1 : 2); }

struct F8 { f32x4 lo, hi; };
__device__ __forceinline__ F8 ld8(const float* p) { F8 r; r.lo = *(const f32x4*)p; r.hi = *(const f32x4*)(p + 4); return r; }
__device__ __forceinline__ void st8bf(bf16_t* p, const float (&v)[8]) { u32x4 w; w.x = pk2(v[0], v[1]); w.y = pk2(v[2], v[3]); w.z = pk2(v[4], v[5]); w.w = pk2(v[6], v[7]); *(u32x4*)p = w; }
__device__ __forceinline__ void ld8bf(const bf16_t* p, float (&v)[8]) { const u32x4 w = *(const u32x4*)p; v[0] = bflo(w.x); v[1] = bfhi(w.x); v[2] = bflo(w.y); v[3] = bfhi(w.y); v[4] = bflo(w.z); v[5] = bfhi(w.z); v[6] = bflo(w.w); v[7] = bfhi(w.w); }
#define ACC8(dst, ai, bj, m) do { _Pragma("unroll") for (int j_ = 0; j_ < 4; ++j_) { dst[j_] = acc[ai][bj][m][0][j_]; dst[4 + j_] = acc[ai][bj][m][1][j_]; } } while (0)
#define F8ARR(dst, f) do { _Pragma("unroll") for (int j_ = 0; j_ < 4; ++j_) { dst[j_] = (f).lo[j_]; dst[4 + j_] = (f).hi[j_]; } } while (0)
__device__ __forceinline__ float rstd_of(const float* rowss, int row) {
    const f32x4* p = (const f32x4*)(rowss + (size_t)row * 16); const f32x4 a = p[0], b = p[1], c = p[2], d = p[3];
    const float s = ((a[0] + a[1]) + (a[2] + a[3])) + ((b[0] + b[1]) + (b[2] + b[3])) + ((c[0] + c[1]) + (c[2] + c[3])) + ((d[0] + d[1]) + (d[2] + d[3]));
    return rsqrtf(s * (1.0f / 1024.0f) + RMS_EPS);
}

struct EpiIn {
    const float* rowss; const float* cin; bf16_t *gb, *v, *uu, *sga, *sgb;
    __device__ __forceinline__ void operator()(EPI_ARGS) const {
        const int sid = sid_of_pm(u.pm), lc = wc * 32 + 8 * fq, pn = u.pn;
        float c0[8], c1[8];
        { const F8 a = ld8(cin + sid * DIN + pn * 256 + lc), b = ld8(cin + sid * DIN + pn * 256 + 128 + lc); F8ARR(c0, a); F8ARR(c1, b); }
#pragma unroll
        for (int ai = 0; ai < 2; ++ai)
#pragma unroll
            for (int m = 0; m < 4; ++m) {
                const int row = u.pm * 256 + ai * 128 + wr * 64 + m * 16 + fr;
                const float rs = rstd_of(rowss, row);
                float z0[8], z1[8]; ACC8(z0, ai, 0, m); ACC8(z1, ai, 1, m);
#pragma unroll
                for (int j = 0; j < 8; ++j) { z0[j] = fmaf(rs, z0[j], c0[j]); z1[j] = fmaf(rs, z1[j], c1[j]); }
                if (pn < 2) { st8bf(gb + (size_t)row * DC + pn * 256 + lc, z0); st8bf(gb + (size_t)row * DC + pn * 256 + 128 + lc, z1); }
                else if (pn < 6) {
#pragma unroll
                    for (int j = 0; j < 8; ++j) z0[j] *= z1[j];
                    st8bf(v + (size_t)row * DC + (pn - 2) * 128 + lc, z0); }
                else if (pn < 8) {
                    const int col0 = (pn - 6) * 256 + lc, col1 = col0 + 128;
                    st8bf(uu + ((size_t)(col0 >> 4) * UROWS + row) * 16 + (col0 & 8), z0);
                    st8bf(uu + ((size_t)(col1 >> 4) * UROWS + row) * 16 + (col1 & 8), z1); }
                else {
#pragma unroll
                    for (int j = 0; j < 8; ++j) { z0[j] = sigm(z0[j]); z1[j] = sigm(z1[j]); }
                    bf16_t* dst = (pn < 12) ? (sga + (size_t)row * D + (pn - 8) * 256 + lc) : (sgb + (size_t)row * D + (pn - 12) * 256 + lc);
                    st8bf(dst, z0); st8bf(dst + 128, z1); }
                asm volatile("" ::: "memory");
            }
    }
};
struct EpiSloc {
    float* sloc;
    __device__ __forceinline__ void operator()(EPI_ARGS) const {
        const int lc = wc * 32 + 8 * fq;
#pragma unroll
        for (int ai = 0; ai < 2; ++ai)
#pragma unroll
            for (int m = 0; m < 4; ++m) {
                const int ch = u.pm * 256 + ai * 128 + wr * 64 + m * 16 + fr;
                if (ch < NCH) {
                    float* dst = sloc + ((size_t)u.g * NCHP + ch) * 256 + lc;
                    *(f32x4*)(dst) = acc[ai][0][m][0]; *(f32x4*)(dst + 4) = acc[ai][0][m][1];
                    *(f32x4*)(dst + 128) = acc[ai][1][m][0]; *(f32x4*)(dst + 132) = acc[ai][1][m][1]; }
                asm volatile("" ::: "memory");
            }
    }
};
struct EpiSsm {
    const bf16_t* uu; const float* dskip; bf16_t* s;
    __device__ __forceinline__ void operator()(EPI_ARGS) const {
        const int lc = wc * 32 + 8 * fq;
#pragma unroll
        for (int bj = 0; bj < 2; ++bj) {
            const int n = u.pn * 256 + bj * 128 + lc, t = n >> 4, hh = n & 8;
            float dk[8]; { const F8 a = ld8(dskip + u.g * 16 + hh); F8ARR(dk, a); }
#pragma unroll
            for (int ai = 0; ai < 2; ++ai)
#pragma unroll
                for (int m = 0; m < 4; ++m) {
                    const int ch = u.pm * 256 + ai * 128 + wr * 64 + m * 16 + fr;
                    if (ch < NCH) {
                        const int tok = ch * 64 + t;
                        float y[8], uv[8]; ACC8(y, ai, bj, m); ld8bf(uu + ((size_t)u.g * UROWS + tok) * 16 + hh, uv);
#pragma unroll
                        for (int j = 0; j < 8; ++j) { const float x = fmaf(dk[j], uv[j], y[j]); y[j] = x * sigm(1.5957691216f * (x + 0.044715f * x * x * x)); }
                        st8bf(s + (size_t)tok * DS + u.g * 16 + hh, y); }
                    asm volatile("" ::: "memory");
                }
        }
    }
};
struct EpiGlu {
    const float* bglu; bf16_t* yb;
    __device__ __forceinline__ void operator()(EPI_ARGS) const {
        const int lc = wc * 32 + 8 * fq, col = u.pn * 128 + lc;
        float bv[8], bg[8]; { const F8 a = ld8(bglu + col), b = ld8(bglu + 1024 + col); F8ARR(bv, a); F8ARR(bg, b); }
#pragma unroll
        for (int ai = 0; ai < 2; ++ai)
#pragma unroll
            for (int m = 0; m < 4; ++m) {
                const int row = u.pm * 256 + ai * 128 + wr * 64 + m * 16 + fr;
                float vv[8], gg[8], sg[8]; ACC8(vv, ai, 0, m); ACC8(gg, ai, 1, m);
                bf16_t* p = yb + (size_t)row * D + col; ld8bf(p, sg);
#pragma unroll
                for (int j = 0; j < 8; ++j) vv[j] = sg[j] * (vv[j] + bv[j]) * sigm(gg[j] + bg[j]);
                st8bf(p, vv);
                asm volatile("" ::: "memory");
            }
    }
};
struct EpiMerge {
    const bf16_t* sga; bf16_t* yb;
    __device__ __forceinline__ void operator()(EPI_ARGS) const {
        const int lc = wc * 32 + 8 * fq;
#pragma unroll
        for (int ai = 0; ai < 2; ++ai)
#pragma unroll
            for (int m = 0; m < 4; ++m) {
                const int row = u.pm * 256 + ai * 128 + wr * 64 + m * 16 + fr;
#pragma unroll
                for (int bj = 0; bj < 2; ++bj) {
                    const size_t o = (size_t)row * D + u.pn * 256 + bj * 128 + lc;
                    float ya[8], a[8], b[8]; ACC8(ya, ai, bj, m); ld8bf(sga + o, a); ld8bf(yb + o, b);
#pragma unroll
                    for (int j = 0; j < 8; ++j) ya[j] = fmaf(a[j], ya[j], b[j]);
                    st8bf(yb + o, ya); }
                asm volatile("" ::: "memory");
            }
    }
};
struct EpiRes {
    float* xlat; float* xctx; const float* gate; const float* gsn; bf16_t* xs; float* rowss; int emit;
    __device__ __forceinline__ void operator()(EPI_ARGS) const {
        const int sid = sid_of_pm(u.pm), lc = wc * 32 + 8 * fq;
        float ss[2][4];
#pragma unroll
        for (int ai = 0; ai < 2; ++ai)
#pragma unroll
            for (int m = 0; m < 4; ++m) ss[ai][m] = 0.f;
#pragma unroll
        for (int bj = 0; bj < 2; ++bj) {
            const int col = u.pn * 256 + bj * 128 + lc;
            float gt[8], gs[8]; { const F8 a = ld8(gate + sid * D + col); F8ARR(gt, a); }
            if (emit) { const F8 b = ld8(gsn + sid * D + col); F8ARR(gs, b); } else {
#pragma unroll
                for (int j = 0; j < 8; ++j) gs[j] = 0.f; }
#pragma unroll
            for (int ai = 0; ai < 2; ++ai)
#pragma unroll
                for (int m = 0; m < 4; ++m) {
                    const int row = u.pm * 256 + ai * 128 + wr * 64 + m * 16 + fr;
                    float* xp = (row < NLAT ? xlat + (size_t)row * D : xctx + (size_t)(row - NLAT) * D) + col;
                    float y[8], x[8]; ACC8(y, ai, bj, m); { const F8 a = ld8(xp); F8ARR(x, a); }
                    float q = 0.f;
#pragma unroll
                    for (int j = 0; j < 8; ++j) { x[j] = fmaf(gt[j], y[j], x[j]); q = fmaf(x[j], x[j], q); }
                    *(f32x4*)xp = (f32x4){x[0], x[1], x[2], x[3]}; *(f32x4*)(xp + 4) = (f32x4){x[4], x[5], x[6], x[7]};
                    if (emit) {
#pragma unroll
                        for (int j = 0; j < 8; ++j) x[j] *= gs[j];
                        st8bf(xs + (size_t)row * D + col, x); }
                    ss[ai][m] += q;
                    asm volatile("" ::: "memory");
                }
        }
        if (emit) {
#pragma unroll
            for (int ai = 0; ai < 2; ++ai)
#pragma unroll
                for (int m = 0; m < 4; ++m) {
                    float q = ss[ai][m]; q += __shfl_xor(q, 16); q += __shfl_xor(q, 32);
                    const int row = u.pm * 256 + ai * 128 + wr * 64 + m * 16 + fr;
                    if (fq == 0) rowss[(size_t)row * 16 + u.pn * 4 + wc] = q; }
        }
    }
};
struct EpiFf {
    const float* rowss; const float* cff; bf16_t* hid;
    __device__ __forceinline__ void operator()(EPI_ARGS) const {
        const int sid = sid_of_pm(u.pm), lc = wc * 32 + 8 * fq;
        float c0[8], c1[8];
        { const F8 a = ld8(cff + sid * 2 * DFF + u.pn * 256 + lc), b = ld8(cff + sid * 2 * DFF + u.pn * 256 + 128 + lc); F8ARR(c0, a); F8ARR(c1, b); }
#pragma unroll
        for (int ai = 0; ai < 2; ++ai)
#pragma unroll
            for (int m = 0; m < 4; ++m) {
                const int row = u.pm * 256 + ai * 128 + wr * 64 + m * 16 + fr;
                const float rs = rstd_of(rowss, row);
                float g[8], uu[8]; ACC8(g, ai, 0, m); ACC8(uu, ai, 1, m);
#pragma unroll
                for (int j = 0; j < 8; ++j) { const float gg = fmaf(rs, g[j], c0[j]), uv = fmaf(rs, uu[j], c1[j]); g[j] = gg * sigm(gg) * uv; }
                st8bf(hid + (size_t)row * DFF + u.pn * 128 + lc, g);
                asm volatile("" ::: "memory");
            }
    }
};

template <int MAP  >
__device__ __forceinline__ int colmap(int v) {
    if (MAP == 1) { if (v >= 512 && v < 1536) { const int q = (v - 512) >> 8, r = (v - 512) & 255; return r < 128 ? 512 + 128 * q + r : 1024 + 128 * q + (r - 128); } return v; }
    if (MAP == 2) { const int q = v >> 8, r = v & 255; return r < 128 ? 128 * q + r : DFF + 128 * q + (r - 128); }
    return v;
}
template <int MAP, bool SILU>
__device__ __forceinline__ void gemv3_item(Ctx& C, int item, const float* W, int ldw, const float* v0, const float* v1, const float* v2, const float* bias, float* out, int ostride) {
    LAS float* red = (LAS float*)C.lds;
    const int vcol = item * 64 + C.lane, oc = colmap<MAP>(vcol);
    float a0 = 0.f, a1 = 0.f, a2 = 0.f;
    const int k0 = C.wave * 128;
#pragma unroll 8
    for (int k = k0; k < k0 + 128; ++k) {
        const float w = W[(size_t)k * ldw + oc];
        float x0 = v0[k], x1 = v1[k], x2 = v2[k];
        if (SILU) { x0 *= sigm(x0); x1 *= sigm(x1); x2 *= sigm(x2); }
        a0 = fmaf(x0, w, a0); a1 = fmaf(x1, w, a1); a2 = fmaf(x2, w, a2);
    }
    red[(C.wave * 3 + 0) * 64 + C.lane] = a0; red[(C.wave * 3 + 1) * 64 + C.lane] = a1; red[(C.wave * 3 + 2) * 64 + C.lane] = a2;
    __syncthreads();
    if (C.tid < 192) {
        const int s = C.tid >> 6, l = C.tid & 63; float r = 0.f;
#pragma unroll
        for (int w = 0; w < 8; ++w) r += red[(w * 3 + s) * 64 + l];
        const int vc = item * 64 + l, o2 = colmap<MAP>(vc);
        out[(size_t)s * ostride + vc] = r + (bias ? bias[o2] : 0.f);
    }
    __syncthreads();
}

template <int MAP  >
__device__ __forceinline__ int vrow_of(int n) {
    if (MAP == 1) { if (n >= 512 && n < 1024) { const int q = (n - 512) >> 7, r = (n - 512) & 127; return 512 + 256 * q + r; }
                    if (n >= 1024 && n < 1536) { const int q = (n - 1024) >> 7, r = (n - 1024) & 127; return 512 + 256 * q + 128 + r; } return n; }
    if (MAP == 2) { return n < 1024 ? 256 * (n >> 7) + (n & 127) : 256 * ((n - 1024) >> 7) + 128 + ((n - 1024) & 127); }
    if (MAP == 3) { return n < DFF ? 256 * (n >> 7) + (n & 127) : 256 * ((n - DFF) >> 7) + 128 + ((n - DFF) & 127); }
    return n;
}
template <int MAP>
__device__ __forceinline__ void transpose_item(const float* W, int K, int N, bf16_t* WT, LAS float* scr, int item, int lane) {
    const int nblk = N / 32, kb = item / nblk, nb = item % nblk, k0 = 64 * kb, n0 = 32 * nb;
#pragma unroll 8
    for (int i = 0; i < 32; ++i) { const int kk = 2 * i + (lane >> 5); scr[kk * 33 + (lane & 31)] = W[(size_t)(k0 + kk) * N + n0 + (lane & 31)]; }
    asm volatile("s_waitcnt lgkmcnt(0)" ::: "memory");
    const int c = lane & 7;
#pragma unroll
    for (int j = 0; j < 4; ++j) { const int n = (lane >> 3) + 8 * j; const LAS float* s = scr + (8 * c) * 33 + n;
        u32x4 o; o.x = pk2(s[0 * 33], s[1 * 33]); o.y = pk2(s[2 * 33], s[3 * 33]); o.z = pk2(s[4 * 33], s[5 * 33]); o.w = pk2(s[6 * 33], s[7 * 33]);
        *(u32x4*)(WT + (size_t)vrow_of<MAP>(n0 + n) * K + k0 + 8 * c) = o; }
    asm volatile("s_waitcnt lgkmcnt(0)" ::: "memory");
}

__device__ __forceinline__ void phase_p0(Ctx& C) {
    float* mod = WSP(float, WS_MOD);
    const float* c0 = C.in[1]; const float* c1 = C.in[1] + D; const float* cc = C.in[3];
    for (int it = C.bid; it < DEPTH * 96; it += C.G) {
        const int l = it / 96, item = it % 96;
        gemv3_item<0, true>(C, item, C.in[4] + (size_t)l * D * 6144, 6144, c0, c1, cc, C.in[5] + (size_t)l * 6144, mod + (size_t)l * 3 * 6144, 6144);
    }
    float* apow = WSP(float, WS_APOW); float* bbar = WSP(float, WS_BBAR);
    const int gt = C.bid * 512 + C.tid, GT = C.G * 512;
    for (int i = gt; i < DEPTH * 2 * NG * 65 * NP; i += GT) {
        const int p = i & 63, e = (i >> 6) % 65, ldg = (i >> 6) / 65;
        const float dt = expf(C.in[14][ldg]);
        const float lr = C.in[12][ldg * 64 + p], li = C.in[13][ldg * 64 + p];
        const float mag = expf((float)e * lr * dt); float s, c; sincos_cw((float)e * (li * dt), s, c);
        apow[(size_t)i * 2] = mag * c; apow[(size_t)i * 2 + 1] = mag * s;
    }
    for (int i = gt; i < DEPTH * 2 * NG * NP; i += GT) {
        const int ldg = i >> 6;
        const float dt = expf(C.in[14][ldg]);
        const float lr = C.in[12][i], li = C.in[13][i];
        const float mag = expf(lr * dt); float s, c; sincos_cw(li * dt, s, c);
        const float ar = mag * c, ai = mag * s, nr = ar - 1.0f, ni = ai, den = lr * lr + li * li;
        const float fr = (nr * lr + ni * li) / den, fi = (ni * lr - nr * li) / den;
        const float* br = C.in[15] + (size_t)i * 16; const float* bi = C.in[16] + (size_t)i * 16;
#pragma unroll
        for (int h = 0; h < 16; ++h) { const float x = br[h], y = bi[h]; bbar[((size_t)i * 16 + h) * 2] = fr * x - fi * y; bbar[((size_t)i * 16 + h) * 2 + 1] = fr * y + fi * x; }
    }
}

__device__ __forceinline__ void phase_prep(Ctx& C, int l) {
    const float* mod = WSP(float, WS_MOD) + (size_t)l * 3 * 6144;
    {
        LAS float* scr = (LAS float*)(C.lds + 8192 + C.wave * 8448);
        unsigned char* wt = C.ws + WS_WT;
        const int gw = C.bid * 8 + C.wave, NGW = C.G * 8;
        constexpr int I0 = 16 * 128, I1 = 8 * 32, I2 = 8 * 64, I3 = 16 * 32, I4 = 16 * 176, I5 = 44 * 32;
        for (int it = gw; it < I0 + I1 + I2 + I3 + I4 + I5; it += NGW) {
            int r = it;
            if (r < I0) { transpose_item<1>(C.in[8] + (size_t)l * D * DIN, D, DIN, (bf16_t*)(wt + WT_IN), scr, r, C.lane); continue; } r -= I0;
            if (r < I1) { transpose_item<0>(C.in[11] + (size_t)l * DC * D, DC, D, (bf16_t*)(wt + WT_OUTA), scr, r, C.lane); continue; } r -= I1;
            if (r < I2) { transpose_item<2>(C.in[20] + (size_t)l * DS * 2048, DS, 2048, (bf16_t*)(wt + WT_GLU), scr, r, C.lane); continue; } r -= I2;
            if (r < I3) { transpose_item<0>(C.in[22] + (size_t)l * D * D, D, D, (bf16_t*)(wt + WT_O), scr, r, C.lane); continue; } r -= I3;
            if (r < I4) { transpose_item<3>(C.in[23] + (size_t)l * D * 2 * DFF, D, 2 * DFF, (bf16_t*)(wt + WT_FFIN), scr, r, C.lane); continue; } r -= I4;
            transpose_item<0>(C.in[24] + (size_t)l * DFF * D, DFF, D, (bf16_t*)(wt + WT_FFOUT), scr, r, C.lane);
        }
        __syncthreads();
    }
    for (int it = C.bid; it < 64 + 88; it += C.G) {
        if (it < 64) gemv3_item<1, false>(C, it, C.in[8] + (size_t)l * D * DIN, DIN, mod + 0, mod + 6144, mod + 2 * 6144, C.in[9] + (size_t)l * DIN, WSP(float, WS_CIN), DIN);
        else gemv3_item<2, false>(C, it - 64, C.in[23] + (size_t)l * D * 2 * DFF, 2 * DFF, mod + 3072, mod + 6144 + 3072, mod + 2 * 6144 + 3072, nullptr, WSP(float, WS_CFF), 2 * DFF);
    }
    const int gt = C.bid * 512 + C.tid, GT = C.G * 512;
    if (l == 0) {
        float* gsv = WSP(float, WS_GSV); const float* modall = WSP(float, WS_MOD);
        for (int i = gt; i < DEPTH * 4 * 3 * D; i += GT) {
            const int k = i & 1023, sid = (i >> 10) % 3, w = ((i >> 10) / 3) & 3, ll = (i >> 10) / 12;
            const float* mv = modall + ((size_t)ll * 3 + sid) * 6144;
            float r;
            if (w == 0) r = C.in[6][ll * D + k] * (1.0f + mv[1024 + k]);
            else if (w == 1) r = C.in[7][ll * D + k] * (1.0f + mv[4096 + k]);
            else if (w == 2) r = mv[2048 + k];
            else r = mv[5120 + k];
            gsv[i] = r;
        }
    }
    const float* apow = WSP(float, WS_APOW) + (size_t)l * 2 * NG * 65 * NP * 2;
    const float* bbar = WSP(float, WS_BBAR) + (size_t)l * 2 * NG * NP * 16 * 2;
    const float* cre = C.in[17] + (size_t)l * 2 * NG * 16 * NP; const float* cim = C.in[18] + (size_t)l * 2 * NG * 16 * NP;
    {
        bf16_t* kc = WSP(bf16_t, WS_KC);
        for (int it2 = C.bid; it2 < (NG * 127 + 1) / 2; it2 += C.G) {
            const int it = it2 * 2 + (C.tid >> 8);
            if (it < NG * 127) {
                const int g = it / 127, dd = it % 127, d = dd - 63, ho = (C.tid >> 4) & 15, hi = C.tid & 15;
                float val = 0.f;
#pragma unroll
                for (int dir = 0; dir < 2; ++dir) {
                    if ((dir == 0 && d >= 0) || (dir == 1 && d <= 0)) {
                        const int e = d < 0 ? -d : d;
                        const float* ap = apow + ((size_t)(dir * NG + g) * 65 + e) * NP * 2;
                        const float* bb = bbar + (size_t)(dir * NG + g) * NP * 32 + hi * 2;
                        const float* cr = cre + ((size_t)(dir * NG + g) * 16 + ho) * NP; const float* ci = cim + ((size_t)(dir * NG + g) * 16 + ho) * NP;
                        for (int p = 0; p < NP; ++p) {
                            const float pr = ap[p * 2], pi = ap[p * 2 + 1], br = bb[p * 32], bi = bb[p * 32 + 1];
                            const float er = pr * br - pi * bi, ei = pr * bi + pi * br;
                            val += cr[p] * er - ci[p] * ei;
                        }
                    }
                }
                kc[(size_t)it * 256 + ho * 16 + hi] = (bf16_t)f2bf(val);
            }
        }
    }
    {
        bf16_t* wg = WSP(bf16_t, WS_WG);
        for (int i = gt; i < NG * 256 * 64; i += GT) {
            const int j = i & 63, n = (i >> 6) & 255, g = i >> 14, dir = n >> 7, ri = (n >> 6) & 1, p = n & 63, e = dir ? j : 63 - j;
            const float* ap = apow + (((size_t)(dir * NG + g) * 65 + e) * NP + p) * 2; const float pr = ap[0], pi = ap[1];
            const float* bb = bbar + ((size_t)(dir * NG + g) * NP + p) * 32;
            float o[16];
#pragma unroll
            for (int h = 0; h < 16; ++h) { const float br = bb[h * 2], bi = bb[h * 2 + 1]; o[h] = ri ? (pr * bi + pi * br) : (pr * br - pi * bi); }
            u32x4 w0, w1; w0.x = pk2(o[0], o[1]); w0.y = pk2(o[2], o[3]); w0.z = pk2(o[4], o[5]); w0.w = pk2(o[6], o[7]);
            w1.x = pk2(o[8], o[9]); w1.y = pk2(o[10], o[11]); w1.z = pk2(o[12], o[13]); w1.w = pk2(o[14], o[15]);
            u32x4* dst = (u32x4*)(wg + ((size_t)g * 256 + n) * 1024 + j * 16); dst[0] = w0; dst[1] = w1;
        }
    }
    {
        bf16_t* mg = WSP(bf16_t, WS_MG);
        for (int i = gt; i < NG * 1024 * 32; i += GT) {
            const int kc8 = i & 31, n = (i >> 5) & 1023, g = i >> 15, t = n >> 4, ho = n & 15, k0 = kc8 * 8, dir = k0 >> 7, ri = (k0 >> 6) & 1, p0 = k0 & 63, e = dir ? 64 - t : t + 1;
            const float* ap = apow + (((size_t)(dir * NG + g) * 65 + e) * NP + p0) * 2;
            const float* cr = cre + ((size_t)(dir * NG + g) * 16 + ho) * NP + p0; const float* ci = cim + ((size_t)(dir * NG + g) * 16 + ho) * NP + p0;
            float o[8];
#pragma unroll
            for (int q = 0; q < 8; ++q) { const float pr = ap[q * 2], pi = ap[q * 2 + 1]; o[q] = ri ? -(cr[q] * pi + ci[q] * pr) : (cr[q] * pr - ci[q] * pi); }
            st8bf(mg + ((size_t)g * 1024 + n) * 256 + k0, o);
        }
    }
    if (l == 0) {
        const float* modall = WSP(float, WS_MOD);
        const int gw = C.bid * 8 + C.wave, NGW = C.G * 8;
        for (int row = gw; row < TR; row += NGW) {
            const int sid = sid_of_row(row);
            const float* src = row < NLAT ? C.in[0] + (size_t)row * D : C.in[2] + (size_t)(row - NLAT) * D;
            float* dst = row < NLAT ? C.out + (size_t)row * D : WSP(float, WS_CTXX) + (size_t)(row - NLAT) * D;
            bf16_t* xs = WSP(bf16_t, WS_XS) + (size_t)row * D;
            float q = 0.f;
#pragma unroll
            for (int j = 0; j < 4; ++j) {
                const int k = j * 256 + C.lane * 4;
                const f32x4 x = *(const f32x4*)(src + k), ng = *(const f32x4*)(C.in[6] + k), sc = *(const f32x4*)(modall + (size_t)sid * 6144 + 1024 + k);
                *(f32x4*)(dst + k) = x; q += (x[0] * x[0] + x[1] * x[1]) + (x[2] * x[2] + x[3] * x[3]);
                const unsigned w0 = pk2(x[0] * ng[0] * (1.f + sc[0]), x[1] * ng[1] * (1.f + sc[1])), w1 = pk2(x[2] * ng[2] * (1.f + sc[2]), x[3] * ng[3] * (1.f + sc[3]));
                *(unsigned long long*)(xs + k) = (unsigned long long)w0 | ((unsigned long long)w1 << 32);
            }
            q = wave_sum(q);
            if (C.lane < 16) WSP(float, WS_ROWSS)[(size_t)row * 16 + C.lane] = C.lane == 0 ? q : 0.f;
        }
    }
}

__device__ __forceinline__ void phase_conv(Ctx& C, int l) {
    const float* cw = C.in[10] + (size_t)l * 3 * DC;
    bf16_t* gb = WSP(bf16_t, WS_GB); const bf16_t* v = WSP(bf16_t, WS_V);
    const int gt = C.bid * 512 + C.tid, GT = C.G * 512;
    for (int i = gt; i < TR * 64; i += GT) {
        const int row = i >> 6, c8 = (i & 63) * 8;
        const bool lat = row < NLAT; const int pos = lat ? (row & 63) : ((row - NLAT) & 255), lastp = lat ? 63 : 255;
        float a[8], b[8], c[8], g[8], w0[8], w1[8], w2[8];
        ld8bf(v + (size_t)row * DC + c8, b);
        if (pos > 0) ld8bf(v + (size_t)(row - 1) * DC + c8, a); else {
#pragma unroll
            for (int j = 0; j < 8; ++j) a[j] = 0.f; }
        if (pos < lastp) ld8bf(v + (size_t)(row + 1) * DC + c8, c); else {
#pragma unroll
            for (int j = 0; j < 8; ++j) c[j] = 0.f; }
        ld8bf(gb + (size_t)row * DC + c8, g);
        { const F8 x = ld8(cw + c8), y = ld8(cw + DC + c8), z = ld8(cw + 2 * DC + c8); F8ARR(w0, x); F8ARR(w1, y); F8ARR(w2, z); }
#pragma unroll
        for (int j = 0; j < 8; ++j) g[j] *= (w0[j] * a[j] + w1[j] * b[j] + w2[j] * c[j]);
        st8bf(gb + (size_t)row * DC + c8, g);
    }
}

__device__ __forceinline__ void phase_scan(Ctx& C, int l) {
    const int i = C.bid * 512 + C.tid;
    if (i >= 2 * 2 * NG * NP) return;
    const int p = i & 63, g = (i >> 6) & 31, dir = (i >> 11) & 1, b = i >> 12;
    const float* ap = WSP(float, WS_APOW) + ((((size_t)(l * 2 + dir) * NG + g) * 65 + 64) * NP + p) * 2;
    const float ar = ap[0], ai = ap[1];
    const float* sl = WSP(float, WS_SLOC) + (size_t)g * NCHP * 256 + dir * 128 + p;
    bf16_t* so = WSP(bf16_t, WS_SIN) + (size_t)g * NCHP * 256 + dir * 128 + p;
    float sr = 0.f, si = 0.f;
    for (int st = 0; st < 260; ++st) {
        int ch;
        if (dir == 0) ch = st < 4 ? 512 + 4 * b + st : 256 * b + (st - 4);
        else ch = st < 4 ? 512 + 4 * b + 3 - st : 256 * b + 255 - (st - 4);
        so[(size_t)ch * 256] = (bf16_t)f2bf(sr); so[(size_t)ch * 256 + 64] = (bf16_t)f2bf(si);
        const float lr = sl[(size_t)ch * 256], li = sl[(size_t)ch * 256 + 64];
        const float nr = ar * sr - ai * si + lr, ni = ar * si + ai * sr + li;
        sr = nr; si = ni;
    }
}

__device__ __forceinline__ void phase_final(Ctx& C) {
    const int gw = C.bid * 8 + C.wave, NGW = C.G * 8;
    const float* fg = C.in[25];
    for (int row = gw; row < NLAT; row += NGW) {
        float* xr = C.out + (size_t)row * D; f32x4 x[4]; float q = 0.f;
#pragma unroll
        for (int j = 0; j < 4; ++j) { x[j] = *(const f32x4*)(xr + j * 256 + C.lane * 4); q += (x[j][0] * x[j][0] + x[j][1] * x[j][1]) + (x[j][2] * x[j][2] + x[j][3] * x[j][3]); }
        q = wave_sum(q); const float rs = rsqrtf(q * (1.0f / 1024.0f) + RMS_EPS);
#pragma unroll
        for (int j = 0; j < 4; ++j) { const f32x4 g = *(const f32x4*)(fg + j * 256 + C.lane * 4); *(f32x4*)(xr + j * 256 + C.lane * 4) = x[j] * rs * g; }
    }
}

template <class Epi>
__device__ __forceinline__ void gemm_plain(Ctx& C, const bf16_t* A, const bf16_t* Bt, int M, int N, int K, const Epi& E) {
    pg8::Seg s; s.A = (const char*)A; s.B = (const char*)Bt; s.tA = 256 * K * 2; s.tB = 256 * K * 2; s.gA = 0; s.gB = 0; s.hA = 128 * K * 2; s.hB = 128 * K * 2; s.kA = 128; s.kB = 128;
    const pg8::Voff v = pg8::voff_plain(C.tid, K * 2, K * 2);
    pg8::Order S; S.init(M / 256, N / 256, 1, C.G, C.bid);
    pg8::gemm_phase<Epi, false>(C.lds, s, s, K / 64, K / 64, v, v, S, E, C.tid);
}

constexpr int PH_PER_LAYER = 10, N_PHASES = 1 + DEPTH * PH_PER_LAYER + 1;

__global__ void __launch_bounds__(512, 2) mega(Args args) {
    extern __shared__ __attribute__((aligned(16))) unsigned char lds_raw[];
    Ctx C;
    C.in = args.in; C.out = args.out; C.ws = args.ws; C.lds = (LAS unsigned char*)lds_raw;
    C.G = gridDim.x; C.bid = blockIdx.x;

    for (int ph = args.ph_lo; ph < args.ph_hi; ++ph) {
        { int t_ = threadIdx.x; asm volatile("" : "+v"(t_)); C.tid = t_; C.lane = t_ & 63; C.wave = __builtin_amdgcn_readfirstlane(t_ >> 6); }
        if (ph == 0) phase_p0(C);
        else if (ph == N_PHASES - 1) phase_final(C);
        else {
            const int l = (ph - 1) / PH_PER_LAYER, sp = (ph - 1) % PH_PER_LAYER;
            unsigned char* wt = C.ws + WS_WT;
            switch ((ONLY_SP >= 0) ? ONLY_SP : sp) {
            case 0: phase_prep(C, l); break;
            case 1: {
                EpiIn E{WSP(float, WS_ROWSS), WSP(float, WS_CIN), WSP(bf16_t, WS_GB), WSP(bf16_t, WS_V), WSP(bf16_t, WS_U), WSP(bf16_t, WS_SGA), WSP(bf16_t, WS_YB)};
                gemm_plain(C, WSP(bf16_t, WS_XS), (const bf16_t*)(wt + WT_IN), TR, DIN, D, E);
            } break;
            case 2: {
                pg8::Seg s; s.A = (const char*)WSP(bf16_t, WS_U); s.B = (const char*)WSP(bf16_t, WS_WG);
                s.tA = 256 * 1024 * 2; s.gA = UROWS * 16 * 2; s.hA = 128 * 1024 * 2; s.kA = 128;
                s.tB = 0; s.gB = 256 * 1024 * 2; s.hB = 128 * 1024 * 2; s.kB = 128;
                const pg8::Voff v = pg8::voff_plain(C.tid, 2048, 2048);
                pg8::Order S; S.init(3, 1, NG, C.G, C.bid);
                EpiSloc E{WSP(float, WS_SLOC)};
                pg8::gemm_phase<EpiSloc, false>(C.lds, s, s, 16, 16, v, v, S, E, C.tid);
                phase_conv(C, l);
            } break;
            case 3: phase_scan(C, l); break;
            case 4: {
                pg8::Seg s0, s1;
                s0.A = (const char*)WSP(bf16_t, WS_U); s0.tA = 256 * 1024 * 2; s0.gA = UROWS * 16 * 2; s0.hA = 128 * 1024 * 2; s0.kA = 128;
                s0.B = (const char*)WSP(bf16_t, WS_KC) + 2 * 63 * 256 - 1536; s0.tB = 8192; s0.gB = 127 * 256 * 2; s0.hB = 4096; s0.kB = -2048;
                s1.A = (const char*)WSP(bf16_t, WS_SIN); s1.tA = 256 * 256 * 2; s1.gA = NCHP * 256 * 2; s1.hA = 128 * 256 * 2; s1.kA = 128;
                s1.B = (const char*)WSP(bf16_t, WS_MG); s1.tB = 256 * 256 * 2; s1.gB = 1024 * 256 * 2; s1.hB = 128 * 256 * 2; s1.kB = 128;
                pg8::Voff v0 = pg8::voff_plain(C.tid, 2048, 32), v1 = pg8::voff_plain(C.tid, 512, 512);
                {
                    int R, Cc; pg8::stage_rc(C.tid * 16, R, Cc); int Rb = (R & ~31) + pg8::perm32(R & 31);
                    v0.b0 = (unsigned)(Rb * 32 - (Cc >> 4) * 512 + (Cc & 15) * 2 + 1536);
                    pg8::stage_rc(C.tid * 16 + 8192, R, Cc); Rb = (R & ~31) + pg8::perm32(R & 31);
                    v0.b1 = (unsigned)(Rb * 32 - (Cc >> 4) * 512 + (Cc & 15) * 2 + 1536);
                }
                pg8::Order S; S.init(3, 4, NG, C.G, C.bid);
                EpiSsm E{WSP(bf16_t, WS_U), C.in[19] + (size_t)l * DS, WSP(bf16_t, WS_S)};
                pg8::gemm_phase<EpiSsm, true>(C.lds, s0, s1, 16, 20, v0, v1, S, E, C.tid);
            } break;
            case 5: {
                EpiGlu E{C.in[21] + (size_t)l * 2048, WSP(bf16_t, WS_YB)};
                gemm_plain(C, WSP(bf16_t, WS_S), (const bf16_t*)(wt + WT_GLU), TR, 2048, DS, E);
            } break;
            case 6: {
                EpiMerge E{WSP(bf16_t, WS_SGA), WSP(bf16_t, WS_YB)};
                gemm_plain(C, WSP(bf16_t, WS_GB), (const bf16_t*)(wt + WT_OUTA), TR, D, DC, E);
            } break;
            case 7: {
                const float* gsv = WSP(float, WS_GSV) + (size_t)l * 4 * 3 * D;
                EpiRes E{C.out, WSP(float, WS_CTXX), gsv + 2 * 3 * D, gsv + 1 * 3 * D, WSP(bf16_t, WS_XS), WSP(float, WS_ROWSS), 1};
                gemm_plain(C, WSP(bf16_t, WS_YB), (const bf16_t*)(wt + WT_O), TR, D, D, E);
            } break;
            case 8: {
                EpiFf E{WSP(float, WS_ROWSS), WSP(float, WS_CFF), WSP(bf16_t, WS_HID)};
                gemm_plain(C, WSP(bf16_t, WS_XS), (const bf16_t*)(wt + WT_FFIN), TR, 2 * DFF, D, E);
            } break;
            case 9: {
                const int ln = l + 1 < DEPTH ? l + 1 : l;
                const float* gsv = WSP(float, WS_GSV);
                EpiRes E{C.out, WSP(float, WS_CTXX), gsv + ((size_t)l * 4 + 3) * 3 * D, gsv + ((size_t)ln * 4 + 0) * 3 * D, WSP(bf16_t, WS_XS), WSP(float, WS_ROWSS), l + 1 < DEPTH ? 1 : 0};
                gemm_plain(C, WSP(bf16_t, WS_HID), (const bf16_t*)(wt + WT_FFOUT), TR, D, DFF, E);
            } break;
            }
        }
        if (ph + 1 < args.ph_hi) {
            if (args.coop) cg::this_grid().sync();
        }
    }
}

extern "C" void kernel_launch(void* const* d_in, const int* in_sizes, int n_in, void* d_out, int out_size, void* d_ws, size_t ws_size, hipStream_t stream) {
    static int grid = 0;
    if (grid == 0) {
        if (n_in != 26 || out_size != NLAT * D || ws_size < WS_END) { fprintf(stderr, "kernel_launch: unexpected shapes (n_in %d out %d ws %zu need %zu)\n", n_in, out_size, ws_size, (size_t)WS_END); grid = -1; return; }
        if (hipFuncSetAttribute((const void*)mega, hipFuncAttributeMaxDynamicSharedMemorySize, LDS_BYTES) != hipSuccess) { fprintf(stderr, "hipFuncSetAttribute failed\n"); grid = -1; return; }
        int dev = 0, cus = 0, per_cu = 0;
        hipGetDevice(&dev); hipDeviceGetAttribute(&cus, hipDeviceAttributeMultiprocessorCount, dev);
        hipOccupancyMaxActiveBlocksPerMultiprocessor(&per_cu, (const void*)mega, 512, LDS_BYTES);
        (void)hipGetLastError();
        if (per_cu < 1) fprintf(stderr, "occupancy query says %d blocks per CU\n", per_cu);
        grid = cus > 0 ? cus : 256;
    }
    if (grid < 0) return;
    Args a{};
    for (int i = 0; i < 26; ++i) a.in[i] = (const float*)d_in[i];
    a.out = (float*)d_out; a.ws = (unsigned char*)d_ws; a.pad = 0;
#if MK_COOP
    a.ph_lo = 0; a.ph_hi = N_PHASES; a.coop = 1;
    void* kargs[] = {&a};
    hipError_t e = hipLaunchCooperativeKernel((const void*)mega, dim3(grid), dim3(512), kargs, LDS_BYTES, stream);
    if (e != hipSuccess) fprintf(stderr, "cooperative launch failed: %s (grid %d)\n", hipGetErrorString(e), grid);
#else
    for (int ph = 0; ph < N_PHASES; ++ph) {
        a.ph_lo = ph; a.ph_hi = ph + 1; a.coop = 0;
        hipLaunchKernelGGL(mega, dim3(grid), dim3(512), LDS_BYTES, stream, a);
    }
#endif
}
```

```cpp
#include <hip/hip_runtime.h>
#include <hip/hip_cooperative_groups.h>
#include <cstdio>
#include <cstdint>
namespace cg = cooperative_groups;

#ifndef ONLY_SP
#define ONLY_SP -1
#endif
#ifndef MK_COOP
#define MK_COOP 1
#endif

#define LAS __attribute__((address_space(3)))
typedef unsigned short bf16_t;
typedef short bf16x8 __attribute__((ext_vector_type(8)));
typedef float f32x4 __attribute__((ext_vector_type(4)));
typedef unsigned u32x4 __attribute__((ext_vector_type(4)));

constexpr int D = 1024, SEQ = 16384, NLAT = 32768, CTXL = 256, NCTX = 512, TR = NLAT + NCTX  ;
constexpr int DEPTH = 4, DC = 512, DS = 512, NG = 32, NP = 64, DFF = 2816, DIN = 4096;
constexpr int NCH = TR / 64  , NCHP = 768, UROWS = NCHP * 64;
constexpr float RMS_EPS = 1e-6f;

constexpr size_t al(size_t x) { return (x + 4095) & ~(size_t)4095; }
constexpr size_t WS_ROWSS = 0;
constexpr size_t WS_MOD = al(WS_ROWSS + (size_t)TR * 16 * 4);
constexpr size_t WS_GSV = al(WS_MOD + (size_t)4 * 3 * 6144 * 4);
constexpr size_t WS_CIN = al(WS_GSV + (size_t)4 * 4 * 3 * 1024 * 4);
constexpr size_t WS_CFF = al(WS_CIN + (size_t)3 * 4096 * 4);
constexpr size_t WS_APOW = al(WS_CFF + (size_t)3 * 5632 * 4);
constexpr size_t WS_BBAR = al(WS_APOW + (size_t)4 * 2 * 32 * 65 * 64 * 2 * 4);
constexpr size_t WS_KC = al(WS_BBAR + (size_t)4 * 2 * 32 * 64 * 16 * 2 * 4);
constexpr size_t WS_WG = al(WS_KC + (size_t)32 * 127 * 256 * 2 + 8192);
constexpr size_t WS_MG = al(WS_WG + (size_t)32 * 256 * 1024 * 2);
constexpr size_t WS_SLOC = al(WS_MG + (size_t)32 * 1024 * 256 * 2);
constexpr size_t WS_SIN = al(WS_SLOC + (size_t)32 * NCHP * 256 * 4);
constexpr size_t WS_CTXX = al(WS_SIN + (size_t)32 * NCHP * 256 * 2);
constexpr size_t WS_WT = al(WS_CTXX + (size_t)NCTX * D * 4);
constexpr size_t WT_IN = 0, WT_OUTA = WT_IN + (size_t)DIN * D * 2, WT_GLU = WT_OUTA + (size_t)D * DC * 2, WT_O = WT_GLU + (size_t)2048 * DS * 2,
                 WT_FFIN = WT_O + (size_t)D * D * 2, WT_FFOUT = WT_FFIN + (size_t)2 * DFF * D * 2, WT_END = WT_FFOUT + (size_t)D * DFF * 2;
constexpr size_t WS_XS = al(WS_WT + WT_END);
constexpr size_t WS_YB = al(WS_XS + (size_t)TR * D * 2);
constexpr size_t WS_GB = al(WS_YB + (size_t)TR * D * 2);
constexpr size_t WS_V = al(WS_GB + (size_t)TR * DC * 2);
constexpr size_t WS_U = al(WS_V + (size_t)TR * DC * 2);
constexpr size_t WS_S = al(WS_U + (size_t)NG * UROWS * 16 * 2);
constexpr size_t WS_SGA = al(WS_S + (size_t)TR * DS * 2);
constexpr size_t WS_OVL_END = al(WS_SGA + (size_t)TR * D * 2);
constexpr size_t WS_HID = WS_GB;
static_assert(WS_HID + (size_t)TR * DFF * 2 <= WS_OVL_END, "hid overlay");
constexpr size_t WS_END = WS_OVL_END;
static_assert(WS_END <= (size_t)512 * 1024 * 1024, "workspace");

constexpr int LDS_BYTES = 147456;

__device__ __forceinline__ unsigned f2bf(float f) { unsigned u = __builtin_bit_cast(unsigned, f); return (u + 0x7fffu + ((u >> 16) & 1u)) >> 16; }
__device__ __forceinline__ unsigned pk2(float lo, float hi) { return f2bf(lo) | (f2bf(hi) << 16); }
__device__ __forceinline__ float bflo(unsigned w) { return __builtin_bit_cast(float, w << 16); }
__device__ __forceinline__ float bfhi(unsigned w) { return __builtin_bit_cast(float, w & 0xffff0000u); }
__device__ __forceinline__ float sigm(float x) { return __builtin_amdgcn_rcpf(1.0f + __expf(-x)); }
__device__ __forceinline__ float wave_sum(float v) {
#pragma unroll
    for (int o = 1; o < 64; o <<= 1) v += __shfl_xor(v, o);
    return v;
}
__device__ __forceinline__ void sincos_cw(float x, float& s, float& c) {
    const float q = rintf(x * 0.63661977236758134f);
    float r = fmaf(-q, 1.5703125f, x);
    r = fmaf(-q, 4.837512969970703125e-4f, r);
    r = fmaf(-q, 7.54978995489188e-8f, r);
    const float r2 = r * r;
    float sp = fmaf(r2, 2.7557319e-6f, -1.9841270e-4f); sp = fmaf(sp, r2, 8.3333333e-3f); sp = fmaf(sp, r2, -1.6666667e-1f); sp = fmaf(sp * r2, r, r);
    float cp = fmaf(r2, -2.7557319e-7f, 2.4801587e-5f); cp = fmaf(cp, r2, -1.3888889e-3f); cp = fmaf(cp, r2, 4.1666667e-2f); cp = fmaf(cp, r2, -0.5f); cp = fmaf(cp, r2, 1.0f);
    const int qi = (int)q & 3;
    const float ss = (qi & 1) ? cp : sp, cc = (qi & 1) ? sp : cp;
    s = (qi & 2) ? -ss : ss; c = ((qi + 1) & 2) ? -cc : cc;
}

namespace pg8 {
constexpr int BM = 256, BK = 64, HALF = 128, HTB = HALF * BK * 2, STAGE_BYTES = 8 * HTB, NXCD = 8, WGM = 8;
__host__ __device__ __forceinline__ int lds_byte(int r, int c) { const int st = (r >> 4) * 2 + (c >> 5), rr = r & 15, cc = c & 31, ob = rr * 64 + cc * 2; return st * 1024 + (ob ^ (((ob >> 9) & 1) << 5)); }
__host__ __device__ __forceinline__ void stage_rc(int b, int& R, int& C) { const int st = b / 1024, sb = b % 1024, swz = sb ^ (((sb >> 9) & 1) << 5); R = (st >> 1) * 16 + swz / 64; C = (st & 1) * 32 + (swz % 64) / 2; }
__host__ __device__ __forceinline__ int perm32(int rho) { const int n = rho >> 4, i = rho & 15; return 8 * (i >> 2) + 4 * n + (i & 3); }

struct Unit { int pm, pn, g; };
struct Seg { const char* A; const char* B; int tA, tB, gA, gB, hA, hB, kA, kB; };

struct Order {
    int nM, nN, nwg, G, c, grouped;
    __device__ void init(int nM_, int nN_, int nG_, int G_, int c_) { nM = nM_; nN = nN_; grouped = nG_ > 1; nwg = nM * nN * nG_; G = G_; c = c_; }
    __device__ bool next(int i, Unit& u) const {
        const long L = (long)i * G + c; if (L >= nwg) return false;
        if (grouped) { const int per = nM * nN; u.g = (int)L / per; const int r = (int)L % per; u.pm = r % nM; u.pn = r / nM; return true; }
        int wgid = (int)L; { const int q = nwg / NXCD, r = nwg % NXCD, xcd = wgid % NXCD, off = wgid / NXCD; wgid = (xcd < r ? xcd * (q + 1) : r * (q + 1) + (xcd - r) * q) + off; }
        const int nig = WGM * nN, gid = wgid / nig, fm = gid * WGM, gsz = (nM - fm) < WGM ? (nM - fm) : WGM;
        u.pm = fm + ((wgid % nig) % gsz); u.pn = (wgid % nig) / gsz; u.g = 0; return true;
    }
};

struct Voff { unsigned a0, a1, b0, b1; };
__device__ __forceinline__ Voff voff_plain(int tid, int ldaB, int ldbB) {
    Voff v; int R, C;
    stage_rc(tid * 16, R, C); { const int Rb = (R & ~31) + perm32(R & 31); v.a0 = (unsigned)(R * ldaB + C * 2); v.b0 = (unsigned)(Rb * ldbB + C * 2); }
    stage_rc(tid * 16 + 8192, R, C); { const int Rb = (R & ~31) + perm32(R & 31); v.a1 = (unsigned)(R * ldaB + C * 2); v.b1 = (unsigned)(Rb * ldbB + C * 2); }
    return v;
}

#define EPI_ARGS const f32x4 (&acc)[2][2][4][2], const pg8::Unit& u, int wr, int wc, int fr, int fq

template <class Epi, bool TWOSEG>
__device__ __forceinline__ void gemm_phase(LAS unsigned char* lds, const Seg s0, const Seg s1, const int nt0, const int nt_in, const Voff v0_in, const Voff v1_in, const Order& S, const Epi& E, const int tid) {
    int nt = nt_in; asm volatile("" : "+s"(nt));
    const int wid = __builtin_amdgcn_readfirstlane(tid >> 6), lane = tid & 63, wr = wid >> 2, wc = wid & 3, fr = lane & 15, fq = lane >> 4;
    const unsigned ldsw = (unsigned)wid * 1024u;
    const int aoff = lds_byte(wr * 64 + fr, fq * 8), boff = lds_byte(wc * 32 + fr, fq * 8);
#define PG8_SA(b, h) (((b) * 2 + (h)) * HTB)
#define PG8_SB(b, h) ((4 + (b) * 2 + (h)) * HTB)
#define PG8_SEG1(t) (TWOSEG && (t) >= nt0)
#define PG8_UA(u, t) (PG8_SEG1(t) ? (s1.A + (long long)((u).g * s1.gA + (u).pm * s1.tA + ((t) - nt0) * s1.kA)) : (s0.A + (long long)((u).g * s0.gA + (u).pm * s0.tA + (t) * s0.kA)))
#define PG8_UB(u, t) (PG8_SEG1(t) ? (s1.B + (long long)((u).g * s1.gB + (u).pn * s1.tB + ((t) - nt0) * s1.kB)) : (s0.B + (long long)((u).g * s0.gB + (u).pn * s0.tB + (t) * s0.kB)))
#define PG8_HA(t) (PG8_SEG1(t) ? s1.hA : s0.hA)
#define PG8_HB(t) (PG8_SEG1(t) ? s1.hB : s0.hB)
#define PG8_STG(bufoff, gptr, o0, o1) do { \
        __builtin_amdgcn_global_load_lds((const unsigned*)((gptr) + (o0)), (LAS unsigned*)(lds + (bufoff) + ldsw), 16, 0, 0); \
        __builtin_amdgcn_global_load_lds((const unsigned*)((gptr) + (o1)), (LAS unsigned*)(lds + (bufoff) + ldsw + 8192), 16, 0, 0); } while (0)
#define PG8_STG_A(bufoff, gptr, t) do { const bool s_ = PG8_SEG1(t); PG8_STG(bufoff, gptr, s_ ? v1.a0 : v0.a0, s_ ? v1.a1 : v0.a1); } while (0)
#define PG8_STG_B(bufoff, gptr, t) do { const bool s_ = PG8_SEG1(t); PG8_STG(bufoff, gptr, s_ ? v1.b0 : v0.b0, s_ ? v1.b1 : v0.b1); } while (0)
#define PG8_LDA(dst, b, h) do { _Pragma("unroll") for (int m = 0; m < 4; ++m) _Pragma("unroll") for (int k = 0; k < 2; ++k) dst[m][k] = *(const LAS bf16x8*)(lds + PG8_SA(b, h) + aoff + m * 2048 + k * 1024); } while (0)
#define PG8_LDB(dst, b, h) do { _Pragma("unroll") for (int n = 0; n < 2; ++n) _Pragma("unroll") for (int k = 0; k < 2; ++k) dst[n][k] = *(const LAS bf16x8*)(lds + PG8_SB(b, h) + boff + n * 2048 + k * 1024); } while (0)
#define PG8_MMA(ai, bj, At, Bt) do { __builtin_amdgcn_s_setprio(1); _Pragma("unroll") for (int m = 0; m < 4; ++m) _Pragma("unroll") for (int n = 0; n < 2; ++n) _Pragma("unroll") for (int k = 0; k < 2; ++k) \
        acc[ai][bj][m][n] = __builtin_amdgcn_mfma_f32_16x16x32_bf16(Bt[n][k], At[m][k], acc[ai][bj][m][n], 0, 0, 0); __builtin_amdgcn_s_setprio(0); } while (0)
#define PG8_WAIT_V(n) asm volatile("s_waitcnt vmcnt(" #n ")" ::: "memory")
#define PG8_WAIT_L(n) asm volatile("s_waitcnt lgkmcnt(" #n ")" ::: "memory")
#define PG8_BAR __builtin_amdgcn_s_barrier()
#define PG8_SCHED __builtin_amdgcn_sched_barrier(0)
    Unit cur, nxt; int ui = 0;
    if (!S.next(0, cur)) return;
    f32x4 acc[2][2][4][2];
#pragma unroll
    for (int a = 0; a < 2; ++a)
#pragma unroll
        for (int b = 0; b < 2; ++b)
#pragma unroll
            for (int m = 0; m < 4; ++m)
#pragma unroll
                for (int n = 0; n < 2; ++n) acc[a][b][m][n] = (f32x4){0.f, 0.f, 0.f, 0.f};
    bf16x8 At[4][2], B0[2][2], B1[2][2];
    Voff v0 = v0_in, v1 = v1_in;
    asm volatile("" : "+v"(v0.a0), "+v"(v0.a1), "+v"(v0.b0), "+v"(v0.b1));
    if (TWOSEG) asm volatile("" : "+v"(v1.a0), "+v"(v1.a1), "+v"(v1.b0), "+v"(v1.b1));
    {
        const char* cA0 = PG8_UA(cur, 0); const char* cB0 = PG8_UB(cur, 0); const char* cA1 = PG8_UA(cur, 1); const char* cB1 = PG8_UB(cur, 1);
        PG8_STG_B(PG8_SB(0, 0), cB0, 0); PG8_STG_A(PG8_SA(0, 0), cA0, 0); PG8_STG_B(PG8_SB(0, 1), cB0 + PG8_HB(0), 0); PG8_STG_A(PG8_SA(0, 1), cA0 + PG8_HA(0), 0);
        if (wr == 1) PG8_BAR;
        PG8_WAIT_V(4); PG8_BAR;
        PG8_STG_B(PG8_SB(1, 0), cB1, 1); PG8_STG_A(PG8_SA(1, 0), cA1, 1); PG8_STG_B(PG8_SB(1, 1), cB1 + PG8_HB(1), 1);
        PG8_WAIT_V(6); PG8_BAR;
    }
    for (;;) {
        const bool has_next = S.next(ui + 1, nxt);
        Unit nu; nu.pm = has_next ? nxt.pm : cur.pm; nu.pn = has_next ? nxt.pn : cur.pn; nu.g = has_next ? nxt.g : cur.g;
#pragma clang loop unroll(disable)
        for (int t = 0; t < nt; t += 2) {
            const bool last = (t == nt - 2);
            const int t1 = t + 1, t2 = last ? 0 : t + 2, t3 = t2 + 1;
            Unit u2; u2.pm = last ? nu.pm : cur.pm; u2.pn = last ? nu.pn : cur.pn; u2.g = last ? nu.g : cur.g;
            const char* a1 = PG8_UA(cur, t1);
            const char* a2 = PG8_UA(u2, t2); const char* b2 = PG8_UB(u2, t2);
            const char* a3 = PG8_UA(u2, t3); const char* b3 = PG8_UB(u2, t3);
            PG8_LDB(B0, 0, 0); PG8_SCHED; PG8_LDA(At, 0, 0); PG8_STG_A(PG8_SA(1, 1), a1 + PG8_HA(t1), t1);
            PG8_WAIT_L(8); PG8_BAR; PG8_WAIT_L(0); PG8_MMA(0, 0, At, B0); PG8_BAR; PG8_SCHED;
            PG8_LDB(B1, 0, 1); PG8_STG_B(PG8_SB(0, 0), b2, t2);
            PG8_BAR; PG8_WAIT_L(0); PG8_MMA(0, 1, At, B1); PG8_BAR;
            PG8_LDA(At, 0, 1); PG8_STG_A(PG8_SA(0, 0), a2, t2);
            PG8_BAR; PG8_WAIT_L(0); PG8_MMA(1, 0, At, B0); PG8_BAR; PG8_SCHED;
            PG8_STG_B(PG8_SB(0, 1), b2 + PG8_HB(t2), t2);
            PG8_WAIT_V(6); PG8_BAR; PG8_MMA(1, 1, At, B1); PG8_BAR;
            PG8_LDB(B0, 1, 0); PG8_SCHED; PG8_LDA(At, 1, 0); PG8_STG_A(PG8_SA(0, 1), a2 + PG8_HA(t2), t2);
            PG8_WAIT_L(8); PG8_BAR; PG8_WAIT_L(0); PG8_MMA(0, 0, At, B0); PG8_BAR; PG8_SCHED;
            PG8_LDB(B1, 1, 1); PG8_STG_B(PG8_SB(1, 0), b3, t3);
            PG8_BAR; PG8_WAIT_L(0); PG8_MMA(0, 1, At, B1); PG8_BAR;
            PG8_LDA(At, 1, 1); PG8_STG_A(PG8_SA(1, 0), a3, t3);
            PG8_BAR; PG8_WAIT_L(0); PG8_MMA(1, 0, At, B0); PG8_BAR; PG8_SCHED;
            PG8_STG_B(PG8_SB(1, 1), b3 + PG8_HB(t3), t3);
            PG8_WAIT_V(6); PG8_BAR; PG8_MMA(1, 1, At, B1); PG8_BAR;
        }
        E(acc, cur, wr, wc, fr, fq);
        if (!has_next) break;
#pragma unroll
        for (int a = 0; a < 2; ++a)
#pragma unroll
            for (int b = 0; b < 2; ++b)
#pragma unroll
                for (int m = 0; m < 4; ++m)
#pragma unroll
                    for (int n = 0; n < 2; ++n) acc[a][b][m][n] = (f32x4){0.f, 0.f, 0.f, 0.f};
        cur = nxt; ++ui;
    }
    PG8_WAIT_V(0);
    if (wr == 0) PG8_BAR;
    PG8_BAR;
#undef PG8_SA
#undef PG8_SB
#undef PG8_SEG1
#undef PG8_UA
#undef PG8_UB
#undef PG8_HA
#undef PG8_HB
#undef PG8_STG
#undef PG8_STG_A
#undef PG8_STG_B
#undef PG8_LDA
#undef PG8_LDB
#undef PG8_MMA
#undef PG8_WAIT_V
#undef PG8_WAIT_L
#undef PG8_BAR
#undef PG8_SCHED
}
}

struct Args { const float* in[26]; float* out; unsigned char* ws; int ph_lo, ph_hi, coop, pad; };

struct Ctx {
    const float* const* in; float* out; unsigned char* ws; LAS unsigned char* lds;
    int tid, lane, wave, G, bid;
};
#define WSP(T, off) ((T*)(C.ws + (off)))
__device__ __forceinline__ int sid_of_pm(int pm) { return pm < 64 ? 0 : (pm < 128 ? 1 : 2); }
__device__ __forceinline__ int sid_of_row(int r) { return r < SEQ ? 0 : (r < NLAT ? 1 : 2); }

struct F8 { f32x4 lo, hi; };
__device__ __forceinline__ F8 ld8(const float* p) { F8 r; r.lo = *(const f32x4*)p; r.hi = *(const f32x4*)(p + 4); return r; }
__device__ __forceinline__ void st8bf(bf16_t* p, const float (&v)[8]) { u32x4 w; w.x = pk2(v[0], v[1]); w.y = pk2(v[2], v[3]); w.z = pk2(v[4], v[5]); w.w = pk2(v[6], v[7]); *(u32x4*)p = w; }
__device__ __forceinline__ void ld8bf(const bf16_t* p, float (&v)[8]) { const u32x4 w = *(const u32x4*)p; v[0] = bflo(w.x); v[1] = bfhi(w.x); v[2] = bflo(w.y); v[3] = bfhi(w.y); v[4] = bflo(w.z); v[5] = bfhi(w.z); v[6] = bflo(w.w); v[7] = bfhi(w.w); }
#define ACC8(dst, ai, bj, m) do { _Pragma("unroll") for (int j_ = 0; j_ < 4; ++j_) { dst[j_] = acc[ai][bj][m][0][j_]; dst[4 + j_] = acc[ai][bj][m][1][j_]; } } while (0)
#define F8ARR(dst, f) do { _Pragma("unroll") for (int j_ = 0; j_ < 4; ++j_) { dst[j_] = (f).lo[j_]; dst[4 + j_] = (f).hi[j_]; } } while (0)
__device__ __forceinline__ float rstd_of(const float* rowss, int row) {
    const f32x4* p = (const f32x4*)(rowss + (size_t)row * 16); const f32x4 a = p[0], b = p[1], c = p[2], d = p[3];
    const float s = ((a[0] + a[1]) + (a[2] + a[3])) + ((b[0] + b[1]) + (b[2] + b[3])) + ((c[0] + c[1]) + (c[2] + c[3])) + ((d[0] + d[1]) + (d[2] + d[3]));
    return rsqrtf(s * (1.0f / 1024.0f) + RMS_EPS);
}

struct EpiIn {
    const float* rowss; const float* cin; bf16_t *gb, *v, *uu, *sga, *sgb;
    __device__ __forceinline__ void operator()(EPI_ARGS) const {
        const int sid = sid_of_pm(u.pm), lc = wc * 32 + 8 * fq, pn = u.pn;
        float c0[8], c1[8];
        { const F8 a = ld8(cin + sid * DIN + pn * 256 + lc), b = ld8(cin + sid * DIN + pn * 256 + 128 + lc); F8ARR(c0, a); F8ARR(c1, b); }
#pragma unroll
        for (int ai = 0; ai < 2; ++ai)
#pragma unroll
            for (int m = 0; m < 4; ++m) {
                const int row = u.pm * 256 + ai * 128 + wr * 64 + m * 16 + fr;
                const float rs = rstd_of(rowss, row);
                float z0[8], z1[8]; ACC8(z0, ai, 0, m); ACC8(z1, ai, 1, m);
#pragma unroll
                for (int j = 0; j < 8; ++j) { z0[j] = fmaf(rs, z0[j], c0[j]); z1[j] = fmaf(rs, z1[j], c1[j]); }
                if (pn < 2) { st8bf(gb + (size_t)row * DC + pn * 256 + lc, z0); st8bf(gb + (size_t)row * DC + pn * 256 + 128 + lc, z1); }
                else if (pn < 6) {
#pragma unroll
                    for (int j = 0; j < 8; ++j) z0[j] *= z1[j];
                    st8bf(v + (size_t)row * DC + (pn - 2) * 128 + lc, z0); }
                else if (pn < 8) {
                    const int col0 = (pn - 6) * 256 + lc, col1 = col0 + 128;
                    st8bf(uu + ((size_t)(col0 >> 4) * UROWS + row) * 16 + (col0 & 8), z0);
                    st8bf(uu + ((size_t)(col1 >> 4) * UROWS + row) * 16 + (col1 & 8), z1); }
                else {
#pragma unroll
                    for (int j = 0; j < 8; ++j) { z0[j] = sigm(z0[j]); z1[j] = sigm(z1[j]); }
                    bf16_t* dst = (pn < 12) ? (sga + (size_t)row * D + (pn - 8) * 256 + lc) : (sgb + (size_t)row * D + (pn - 12) * 256 + lc);
                    st8bf(dst, z0); st8bf(dst + 128, z1); }
                asm volatile("" ::: "memory");
            }
    }
};
struct EpiSloc {
    float* sloc;
    __device__ __forceinline__ void operator()(EPI_ARGS) const {
        const int lc = wc * 32 + 8 * fq;
#pragma unroll
        for (int ai = 0; ai < 2; ++ai)
#pragma unroll
            for (int m = 0; m < 4; ++m) {
                const int ch = u.pm * 256 + ai * 128 + wr * 64 + m * 16 + fr;
                if (ch < NCH) {
                    float* dst = sloc + ((size_t)u.g * NCHP + ch) * 256 + lc;
                    *(f32x4*)(dst) = acc[ai][0][m][0]; *(f32x4*)(dst + 4) = acc[ai][0][m][1];
                    *(f32x4*)(dst + 128) = acc[ai][1][m][0]; *(f32x4*)(dst + 132) = acc[ai][1][m][1]; }
                asm volatile("" ::: "memory");
            }
    }
};
struct EpiSsm {
    const bf16_t* uu; const float* dskip; bf16_t* s;
    __device__ __forceinline__ void operator()(EPI_ARGS) const {
        const int lc = wc * 32 + 8 * fq;
#pragma unroll
        for (int bj = 0; bj < 2; ++bj) {
            const int n = u.pn * 256 + bj * 128 + lc, t = n >> 4, hh = n & 8;
            float dk[8]; { const F8 a = ld8(dskip + u.g * 16 + hh); F8ARR(dk, a); }
#pragma unroll
            for (int ai = 0; ai < 2; ++ai)
#pragma unroll
                for (int m = 0; m < 4; ++m) {
                    const int ch = u.pm * 256 + ai * 128 + wr * 64 + m * 16 + fr;
                    if (ch < NCH) {
                        const int tok = ch * 64 + t;
                        float y[8], uv[8]; ACC8(y, ai, bj, m); ld8bf(uu + ((size_t)u.g * UROWS + tok) * 16 + hh, uv);
#pragma unroll
                        for (int j = 0; j < 8; ++j) { const float x = fmaf(dk[j], uv[j], y[j]); y[j] = x * sigm(1.5957691216f * (x + 0.044715f * x * x * x)); }
                        st8bf(s + (size_t)tok * DS + u.g * 16 + hh, y); }
                    asm volatile("" ::: "memory");
                }
        }
    }
};
struct EpiGlu {
    const float* bglu; bf16_t* yb;
    __device__ __forceinline__ void operator()(EPI_ARGS) const {
        const int lc = wc * 32 + 8 * fq, col = u.pn * 128 + lc;
        float bv[8], bg[8]; { const F8 a = ld8(bglu + col), b = ld8(bglu + 1024 + col); F8ARR(bv, a); F8ARR(bg, b); }
#pragma unroll
        for (int ai = 0; ai < 2; ++ai)
#pragma unroll
            for (int m = 0; m < 4; ++m) {
                const int row = u.pm * 256 + ai * 128 + wr * 64 + m * 16 + fr;
                float vv[8], gg[8], sg[8]; ACC8(vv, ai, 0, m); ACC8(gg, ai, 1, m);
                bf16_t* p = yb + (size_t)row * D + col; ld8bf(p, sg);
#pragma unroll
                for (int j = 0; j < 8; ++j) vv[j] = sg[j] * (vv[j] + bv[j]) * sigm(gg[j] + bg[j]);
                st8bf(p, vv);
                asm volatile("" ::: "memory");
            }
    }
};
struct EpiMerge {
    const bf16_t* sga; bf16_t* yb;
    __device__ __forceinline__ void operator()(EPI_ARGS) const {
        const int lc = wc * 32 + 8 * fq;
#pragma unroll
        for (int ai = 0; ai < 2; ++ai)
#pragma unroll
            for (int m = 0; m < 4; ++m) {
                const int row = u.pm * 256 + ai * 128 + wr * 64 + m * 16 + fr;
#pragma unroll
                for (int bj = 0; bj < 2; ++bj) {
                    const size_t o = (size_t)row * D + u.pn * 256 + bj * 128 + lc;
                    float ya[8], a[8], b[8]; ACC8(ya, ai, bj, m); ld8bf(sga + o, a); ld8bf(yb + o, b);
#pragma unroll
                    for (int j = 0; j < 8; ++j) ya[j] = fmaf(a[j], ya[j], b[j]);
                    st8bf(yb + o, ya); }
                asm volatile("" ::: "memory");
            }
    }
};
struct EpiRes {
    float* xlat; float* xctx; const float* gate; const float* gsn; bf16_t* xs; float* rowss; int emit;
    __device__ __forceinline__ void operator()(EPI_ARGS) const {
        const int sid = sid_of_pm(u.pm), lc = wc * 32 + 8 * fq;
        float ss[2][4];
#pragma unroll
        for (int ai = 0; ai < 2; ++ai)
#pragma unroll
            for (int m = 0; m < 4; ++m) ss[ai][m] = 0.f;
#pragma unroll
        for (int bj = 0; bj < 2; ++bj) {
            const int col = u.pn * 256 + bj * 128 + lc;
            float gt[8], gs[8]; { const F8 a = ld8(gate + sid * D + col); F8ARR(gt, a); }
            if (emit) { const F8 b = ld8(gsn + sid * D + col); F8ARR(gs, b); } else {
#pragma unroll
                for (int j = 0; j < 8; ++j) gs[j] = 0.f; }
#pragma unroll
            for (int ai = 0; ai < 2; ++ai)
#pragma unroll
                for (int m = 0; m < 4; ++m) {
                    const int row = u.pm * 256 + ai * 128 + wr * 64 + m * 16 + fr;
                    float* xp = (row < NLAT ? xlat + (size_t)row * D : xctx + (size_t)(row - NLAT) * D) + col;
                    float y[8], x[8]; ACC8(y, ai, bj, m); { const F8 a = ld8(xp); F8ARR(x, a); }
                    float q = 0.f;
#pragma unroll
                    for (int j = 0; j < 8; ++j) { x[j] = fmaf(gt[j], y[j], x[j]); q = fmaf(x[j], x[j], q); }
                    *(f32x4*)xp = (f32x4){x[0], x[1], x[2], x[3]}; *(f32x4*)(xp + 4) = (f32x4){x[4], x[5], x[6], x[7]};
                    if (emit) {
#pragma unroll
                        for (int j = 0; j < 8; ++j) x[j] *= gs[j];
                        st8bf(xs + (size_t)row * D + col, x); }
                    ss[ai][m] += q;
                    asm volatile("" ::: "memory");
                }
        }
        if (emit) {
#pragma unroll
            for (int ai = 0; ai < 2; ++ai)
#pragma unroll
                for (int m = 0; m < 4; ++m) {
                    float q = ss[ai][m]; q += __shfl_xor(q, 16); q += __shfl_xor(q, 32);
                    const int row = u.pm * 256 + ai * 128 + wr * 64 + m * 16 + fr;
                    if (fq == 0) rowss[(size_t)row * 16 + u.pn * 4 + wc] = q; }
        }
    }
};
struct EpiFf {
    const float* rowss; const float* cff; bf16_t* hid;
    __device__ __forceinline__ void operator()(EPI_ARGS) const {
        const int sid = sid_of_pm(u.pm), lc = wc * 32 + 8 * fq;
        float c0[8], c1[8];
        { const F8 a = ld8(cff + sid * 2 * DFF + u.pn * 256 + lc), b = ld8(cff + sid * 2 * DFF + u.pn * 256 + 128 + lc); F8ARR(c0, a); F8ARR(c1, b); }
#pragma unroll
        for (int ai = 0; ai < 2; ++ai)
#pragma unroll
            for (int m = 0; m < 4; ++m) {
                const int row = u.pm * 256 + ai * 128 + wr * 64 + m * 16 + fr;
                const float rs = rstd_of(rowss, row);
                float g[8], uu[8]; ACC8(g, ai, 0, m); ACC8(uu, ai, 1, m);
#pragma unroll
                for (int j = 0; j < 8; ++j) { const float gg = fmaf(rs, g[j], c0[j]), uv = fmaf(rs, uu[j], c1[j]); g[j] = gg * sigm(gg) * uv; }
                st8bf(hid + (size_t)row * DFF + u.pn * 128 + lc, g);
                asm volatile("" ::: "memory");
            }
    }
};

template <int MAP  >
__device__ __forceinline__ int colmap(int v) {
    if (MAP == 1) { if (v >= 512 && v < 1536) { const int q = (v - 512) >> 8, r = (v - 512) & 255; return r < 128 ? 512 + 128 * q + r : 1024 + 128 * q + (r - 128); } return v; }
    if (MAP == 2) { const int q = v >> 8, r = v & 255; return r < 128 ? 128 * q + r : DFF + 128 * q + (r - 128); }
    return v;
}
template <int MAP, bool SILU>
__device__ __forceinline__ void gemv3_item(Ctx& C, int item, const float* W, int ldw, const float* v0, const float* v1, const float* v2, const float* bias, float* out, int ostride) {
    LAS float* red = (LAS float*)C.lds;
    const int vcol = item * 64 + C.lane, oc = colmap<MAP>(vcol);
    float a0 = 0.f, a1 = 0.f, a2 = 0.f;
    const int k0 = C.wave * 128;
#pragma unroll 8
    for (int k = k0; k < k0 + 128; ++k) {
        const float w = W[(size_t)k * ldw + oc];
        float x0 = v0[k], x1 = v1[k], x2 = v2[k];
        if (SILU) { x0 *= sigm(x0); x1 *= sigm(x1); x2 *= sigm(x2); }
        a0 = fmaf(x0, w, a0); a1 = fmaf(x1, w, a1); a2 = fmaf(x2, w, a2);
    }
    red[(C.wave * 3 + 0) * 64 + C.lane] = a0; red[(C.wave * 3 + 1) * 64 + C.lane] = a1; red[(C.wave * 3 + 2) * 64 + C.lane] = a2;
    __syncthreads();
    if (C.tid < 192) {
        const int s = C.tid >> 6, l = C.tid & 63; float r = 0.f;
#pragma unroll
        for (int w = 0; w < 8; ++w) r += red[(w * 3 + s) * 64 + l];
        const int vc = item * 64 + l, o2 = colmap<MAP>(vc);
        out[(size_t)s * ostride + vc] = r + (bias ? bias[o2] : 0.f);
    }
    __syncthreads();
}

template <int MAP  >
__device__ __forceinline__ int vrow_of(int n) {
    if (MAP == 1) { if (n >= 512 && n < 1024) { const int q = (n - 512) >> 7, r = (n - 512) & 127; return 512 + 256 * q + r; }
                    if (n >= 1024 && n < 1536) { const int q = (n - 1024) >> 7, r = (n - 1024) & 127; return 512 + 256 * q + 128 + r; } return n; }
    if (MAP == 2) { return n < 1024 ? 256 * (n >> 7) + (n & 127) : 256 * ((n - 1024) >> 7) + 128 + ((n - 1024) & 127); }
    if (MAP == 3) { return n < DFF ? 256 * (n >> 7) + (n & 127) : 256 * ((n - DFF) >> 7) + 128 + ((n - DFF) & 127); }
    return n;
}
template <int MAP>
__device__ __forceinline__ void transpose_item(const float* W, int K, int N, bf16_t* WT, LAS float* scr, int item, int lane) {
    const int nblk = N / 32, kb = item / nblk, nb = item % nblk, k0 = 64 * kb, n0 = 32 * nb;
#pragma unroll 8
    for (int i = 0; i < 32; ++i) { const int kk = 2 * i + (lane >> 5); scr[kk * 33 + (lane & 31)] = W[(size_t)(k0 + kk) * N + n0 + (lane & 31)]; }
    asm volatile("s_waitcnt lgkmcnt(0)" ::: "memory");
    const int c = lane & 7;
#pragma unroll
    for (int j = 0; j < 4; ++j) { const int n = (lane >> 3) + 8 * j; const LAS float* s = scr + (8 * c) * 33 + n;
        u32x4 o; o.x = pk2(s[0 * 33], s[1 * 33]); o.y = pk2(s[2 * 33], s[3 * 33]); o.z = pk2(s[4 * 33], s[5 * 33]); o.w = pk2(s[6 * 33], s[7 * 33]);
        *(u32x4*)(WT + (size_t)vrow_of<MAP>(n0 + n) * K + k0 + 8 * c) = o; }
    asm volatile("s_waitcnt lgkmcnt(0)" ::: "memory");
}

__device__ __forceinline__ void phase_p0(Ctx& C) {
    float* mod = WSP(float, WS_MOD);
    const float* c0 = C.in[1]; const float* c1 = C.in[1] + D; const float* cc = C.in[3];
    for (int it = C.bid; it < DEPTH * 96; it += C.G) {
        const int l = it / 96, item = it % 96;
        gemv3_item<0, true>(C, item, C.in[4] + (size_t)l * D * 6144, 6144, c0, c1, cc, C.in[5] + (size_t)l * 6144, mod + (size_t)l * 3 * 6144, 6144);
    }
    float* apow = WSP(float, WS_APOW); float* bbar = WSP(float, WS_BBAR);
    const int gt = C.bid * 512 + C.tid, GT = C.G * 512;
    for (int i = gt; i < DEPTH * 2 * NG * 65 * NP; i += GT) {
        const int p = i & 63, e = (i >> 6) % 65, ldg = (i >> 6) / 65;
        const float dt = expf(C.in[14][ldg]);
        const float lr = C.in[12][ldg * 64 + p], li = C.in[13][ldg * 64 + p];
        const float mag = expf((float)e * lr * dt); float s, c; sincos_cw((float)e * (li * dt), s, c);
        apow[(size_t)i * 2] = mag * c; apow[(size_t)i * 2 + 1] = mag * s;
    }
    for (int i = gt; i < DEPTH * 2 * NG * NP; i += GT) {
        const int ldg = i >> 6;
        const float dt = expf(C.in[14][ldg]);
        const float lr = C.in[12][i], li = C.in[13][i];
        const float mag = expf(lr * dt); float s, c; sincos_cw(li * dt, s, c);
        const float ar = mag * c, ai = mag * s, nr = ar - 1.0f, ni = ai, den = lr * lr + li * li;
        const float fr = (nr * lr + ni * li) / den, fi = (ni * lr - nr * li) / den;
        const float* br = C.in[15] + (size_t)i * 16; const float* bi = C.in[16] + (size_t)i * 16;
#pragma unroll
        for (int h = 0; h < 16; ++h) { const float x = br[h], y = bi[h]; bbar[((size_t)i * 16 + h) * 2] = fr * x - fi * y; bbar[((size_t)i * 16 + h) * 2 + 1] = fr * y + fi * x; }
    }
}

__device__ __forceinline__ void phase_prep(Ctx& C, int l) {
    const float* mod = WSP(float, WS_MOD) + (size_t)l * 3 * 6144;
    {
        LAS float* scr = (LAS float*)(C.lds + 8192 + C.wave * 8448);
        unsigned char* wt = C.ws + WS_WT;
        const int gw = C.bid * 8 + C.wave, NGW = C.G * 8;
        constexpr int I0 = 16 * 128, I1 = 8 * 32, I2 = 8 * 64, I3 = 16 * 32, I4 = 16 * 176, I5 = 44 * 32;
        for (int it = gw; it < I0 + I1 + I2 + I3 + I4 + I5; it += NGW) {
            int r = it;
            if (r < I0) { transpose_item<1>(C.in[8] + (size_t)l * D * DIN, D, DIN, (bf16_t*)(wt + WT_IN), scr, r, C.lane); continue; } r -= I0;
            if (r < I1) { transpose_item<0>(C.in[11] + (size_t)l * DC * D, DC, D, (bf16_t*)(wt + WT_OUTA), scr, r, C.lane); continue; } r -= I1;
            if (r < I2) { transpose_item<2>(C.in[20] + (size_t)l * DS * 2048, DS, 2048, (bf16_t*)(wt + WT_GLU), scr, r, C.lane); continue; } r -= I2;
            if (r < I3) { transpose_item<0>(C.in[22] + (size_t)l * D * D, D, D, (bf16_t*)(wt + WT_O), scr, r, C.lane); continue; } r -= I3;
            if (r < I4) { transpose_item<3>(C.in[23] + (size_t)l * D * 2 * DFF, D, 2 * DFF, (bf16_t*)(wt + WT_FFIN), scr, r, C.lane); continue; } r -= I4;
            transpose_item<0>(C.in[24] + (size_t)l * DFF * D, DFF, D, (bf16_t*)(wt + WT_FFOUT), scr, r, C.lane);
        }
        __syncthreads();
    }
    for (int it = C.bid; it < 64 + 88; it += C.G) {
        if (it < 64) gemv3_item<1, false>(C, it, C.in[8] + (size_t)l * D * DIN, DIN, mod + 0, mod + 6144, mod + 2 * 6144, C.in[9] + (size_t)l * DIN, WSP(float, WS_CIN), DIN);
        else gemv3_item<2, false>(C, it - 64, C.in[23] + (size_t)l * D * 2 * DFF, 2 * DFF, mod + 3072, mod + 6144 + 3072, mod + 2 * 6144 + 3072, nullptr, WSP(float, WS_CFF), 2 * DFF);
    }
    const int gt = C.bid * 512 + C.tid, GT = C.G * 512;
    if (l == 0) {
        float* gsv = WSP(float, WS_GSV); const float* modall = WSP(float, WS_MOD);
        for (int i = gt; i < DEPTH * 4 * 3 * D; i += GT) {
            const int k = i & 1023, sid = (i >> 10) % 3, w = ((i >> 10) / 3) & 3, ll = (i >> 10) / 12;
            const float* mv = modall + ((size_t)ll * 3 + sid) * 6144;
            float r;
            if (w == 0) r = C.in[6][ll * D + k] * (1.0f + mv[1024 + k]);
            else if (w == 1) r = C.in[7][ll * D + k] * (1.0f + mv[4096 + k]);
            else if (w == 2) r = mv[2048 + k];
            else r = mv[5120 + k];
            gsv[i] = r;
        }
    }
    const float* apow = WSP(float, WS_APOW) + (size_t)l * 2 * NG * 65 * NP * 2;
    const float* bbar = WSP(float, WS_BBAR) + (size_t)l * 2 * NG * NP * 16 * 2;
    const float* cre = C.in[17] + (size_t)l * 2 * NG * 16 * NP; const float* cim = C.in[18] + (size_t)l * 2 * NG * 16 * NP;
    {
        bf16_t* kc = WSP(bf16_t, WS_KC);
        for (int it2 = C.bid; it2 < (NG * 127 + 1) / 2; it2 += C.G) {
            const int it = it2 * 2 + (C.tid >> 8);
            if (it < NG * 127) {
                const int g = it / 127, dd = it % 127, d = dd - 63, ho = (C.tid >> 4) & 15, hi = C.tid & 15;
                float val = 0.f;
#pragma unroll
                for (int dir = 0; dir < 2; ++dir) {
                    if ((dir == 0 && d >= 0) || (dir == 1 && d <= 0)) {
                        const int e = d < 0 ? -d : d;
                        const float* ap = apow + ((size_t)(dir * NG + g) * 65 + e) * NP * 2;
                        const float* bb = bbar + (size_t)(dir * NG + g) * NP * 32 + hi * 2;
                        const float* cr = cre + ((size_t)(dir * NG + g) * 16 + ho) * NP; const float* ci = cim + ((size_t)(dir * NG + g) * 16 + ho) * NP;
                        for (int p = 0; p < NP; ++p) {
                            const float pr = ap[p * 2], pi = ap[p * 2 + 1], br = bb[p * 32], bi = bb[p * 32 + 1];
                            const float er = pr * br - pi * bi, ei = pr * bi + pi * br;
                            val += cr[p] * er - ci[p] * ei;
                        }
                    }
                }
                kc[(size_t)it * 256 + ho * 16 + hi] = (bf16_t)f2bf(val);
            }
        }
    }
    {
        bf16_t* wg = WSP(bf16_t, WS_WG);
        for (int i = gt; i < NG * 256 * 64; i += GT) {
            const int j = i & 63, n = (i >> 6) & 255, g = i >> 14, dir = n >> 7, ri = (n >> 6) & 1, p = n & 63, e = dir ? j : 63 - j;
            const float* ap = apow + (((size_t)(dir * NG + g) * 65 + e) * NP + p) * 2; const float pr = ap[0], pi = ap[1];
            const float* bb = bbar + ((size_t)(dir * NG + g) * NP + p) * 32;
            float o[16];
#pragma unroll
            for (int h = 0; h < 16; ++h) { const float br = bb[h * 2], bi = bb[h * 2 + 1]; o[h] = ri ? (pr * bi + pi * br) : (pr * br - pi * bi); }
            u32x4 w0, w1; w0.x = pk2(o[0], o[1]); w0.y = pk2(o[2], o[3]); w0.z = pk2(o[4], o[5]); w0.w = pk2(o[6], o[7]);
            w1.x = pk2(o[8], o[9]); w1.y = pk2(o[10], o[11]); w1.z = pk2(o[12], o[13]); w1.w = pk2(o[14], o[15]);
            u32x4* dst = (u32x4*)(wg + ((size_t)g * 256 + n) * 1024 + j * 16); dst[0] = w0; dst[1] = w1;
        }
    }
    {
        bf16_t* mg = WSP(bf16_t, WS_MG);
        for (int i = gt; i < NG * 1024 * 32; i += GT) {
            const int kc8 = i & 31, n = (i >> 5) & 1023, g = i >> 15, t = n >> 4, ho = n & 15, k0 = kc8 * 8, dir = k0 >> 7, ri = (k0 >> 6) & 1, p0 = k0 & 63, e = dir ? 64 - t : t + 1;
            const float* ap = apow + (((size_t)(dir * NG + g) * 65 + e) * NP + p0) * 2;
            const float* cr = cre + ((size_t)(dir * NG + g) * 16 + ho) * NP + p0; const float* ci = cim + ((size_t)(dir * NG + g) * 16 + ho) * NP + p0;
            float o[8];
#pragma unroll
            for (int q = 0; q < 8; ++q) { const float pr = ap[q * 2], pi = ap[q * 2 + 1]; o[q] = ri ? -(cr[q] * pi + ci[q] * pr) : (cr[q] * pr - ci[q] * pi); }
            st8bf(mg + ((size_t)g * 1024 + n) * 256 + k0, o);
        }
    }
    if (l == 0) {
        const float* modall = WSP(float, WS_MOD);
        const int gw = C.bid * 8 + C.wave, NGW = C.G * 8;
        for (int row = gw; row < TR; row += NGW) {
            const int sid = sid_of_row(row);
            const float* src = row < NLAT ? C.in[0] + (size_t)row * D : C.in[2] + (size_t)(row - NLAT) * D;
            float* dst = row < NLAT ? C.out + (size_t)row * D : WSP(float, WS_CTXX) + (size_t)(row - NLAT) * D;
            bf16_t* xs = WSP(bf16_t, WS_XS) + (size_t)row * D;
            float q = 0.f;
#pragma unroll
            for (int j = 0; j < 4; ++j) {
                const int k = j * 256 + C.lane * 4;
                const f32x4 x = *(const f32x4*)(src + k), ng = *(const f32x4*)(C.in[6] + k), sc = *(const f32x4*)(modall + (size_t)sid * 6144 + 1024 + k);
                *(f32x4*)(dst + k) = x; q += (x[0] * x[0] + x[1] * x[1]) + (x[2] * x[2] + x[3] * x[3]);
                const unsigned w0 = pk2(x[0] * ng[0] * (1.f + sc[0]), x[1] * ng[1] * (1.f + sc[1])), w1 = pk2(x[2] * ng[2] * (1.f + sc[2]), x[3] * ng[3] * (1.f + sc[3]));
                *(unsigned long long*)(xs + k) = (unsigned long long)w0 | ((unsigned long long)w1 << 32);
            }
            q = wave_sum(q);
            if (C.lane < 16) WSP(float, WS_ROWSS)[(size_t)row * 16 + C.lane] = C.lane == 0 ? q : 0.f;
        }
    }
}

__device__ __forceinline__ void phase_conv(Ctx& C, int l) {
    const float* cw = C.in[10] + (size_t)l * 3 * DC;
    bf16_t* gb = WSP(bf16_t, WS_GB); const bf16_t* v = WSP(bf16_t, WS_V);
    const int gt = C.bid * 512 + C.tid, GT = C.G * 512;
    for (int i = gt; i < TR * 64; i += GT) {
        const int row = i >> 6, c8 = (i & 63) * 8;
        const bool lat = row < NLAT; const int pos = lat ? (row & 63) : ((row - NLAT) & 255), lastp = lat ? 63 : 255;
        float a[8], b[8], c[8], g[8], w0[8], w1[8], w2[8];
        ld8bf(v + (size_t)row * DC + c8, b);
        if (pos > 0) ld8bf(v + (size_t)(row - 1) * DC + c8, a); else {
#pragma unroll
            for (int j = 0; j < 8; ++j) a[j] = 0.f; }
        if (pos < lastp) ld8bf(v + (size_t)(row + 1) * DC + c8, c); else {
#pragma unroll
            for (int j = 0; j < 8; ++j) c[j] = 0.f; }
        ld8bf(gb + (size_t)row * DC + c8, g);
        { const F8 x = ld8(cw + c8), y = ld8(cw + DC + c8), z = ld8(cw + 2 * DC + c8); F8ARR(w0, x); F8ARR(w1, y); F8ARR(w2, z); }
#pragma unroll
        for (int j = 0; j < 8; ++j) g[j] *= (w0[j] * a[j] + w1[j] * b[j] + w2[j] * c[j]);
        st8bf(gb + (size_t)row * DC + c8, g);
    }
}

__device__ __forceinline__ void phase_scan(Ctx& C, int l) {
    const int i = C.bid * 512 + C.tid;
    if (i >= 2 * 2 * NG * NP) return;
    const int p = i & 63, g = (i >> 6) & 31, dir = (i >> 11) & 1, b = i >> 12;
    const float* ap = WSP(float, WS_APOW) + ((((size_t)(l * 2 + dir) * NG + g) * 65 + 64) * NP + p) * 2;
    const float ar = ap[0], ai = ap[1];
    const float* sl = WSP(float, WS_SLOC) + (size_t)g * NCHP * 256 + dir * 128 + p;
    bf16_t* so = WSP(bf16_t, WS_SIN) + (size_t)g * NCHP * 256 + dir * 128 + p;
    float sr = 0.f, si = 0.f;
    for (int st = 0; st < 260; ++st) {
        int ch;
        if (dir == 0) ch = st < 4 ? 512 + 4 * b + st : 256 * b + (st - 4);
        else ch = st < 4 ? 512 + 4 * b + 3 - st : 256 * b + 255 - (st - 4);
        so[(size_t)ch * 256] = (bf16_t)f2bf(sr); so[(size_t)ch * 256 + 64] = (bf16_t)f2bf(si);
        const float lr = sl[(size_t)ch * 256], li = sl[(size_t)ch * 256 + 64];
        const float nr = ar * sr - ai * si + lr, ni = ar * si + ai * sr + li;
        sr = nr; si = ni;
    }
}

__device__ __forceinline__ void phase_final(Ctx& C) {
    const int gw = C.bid * 8 + C.wave, NGW = C.G * 8;
    const float* fg = C.in[25];
    for (int row = gw; row < NLAT; row += NGW) {
        float* xr = C.out + (size_t)row * D; f32x4 x[4]; float q = 0.f;
#pragma unroll
        for (int j = 0; j < 4; ++j) { x[j] = *(const f32x4*)(xr + j * 256 + C.lane * 4); q += (x[j][0] * x[j][0] + x[j][1] * x[j][1]) + (x[j][2] * x[j][2] + x[j][3] * x[j][3]); }
        q = wave_sum(q); const float rs = rsqrtf(q * (1.0f / 1024.0f) + RMS_EPS);
#pragma unroll
        for (int j = 0; j < 4; ++j) { const f32x4 g = *(const f32x4*)(fg + j * 256 + C.lane * 4); *(f32x4*)(xr + j * 256 + C.lane * 4) = x[j] * rs * g; }
    }
}

template <class Epi>
__device__ __forceinline__ void gemm_plain(Ctx& C, const bf16_t* A, const bf16_t* Bt, int M, int N, int K, const Epi& E) {
    pg8::Seg s; s.A = (const char*)A; s.B = (const char*)Bt; s.tA = 256 * K * 2; s.tB = 256 * K * 2; s.gA = 0; s.gB = 0; s.hA = 128 * K * 2; s.hB = 128 * K * 2; s.kA = 128; s.kB = 128;
    const pg8::Voff v = pg8::voff_plain(C.tid, K * 2, K * 2);
    pg8::Order S; S.init(M / 256, N / 256, 1, C.G, C.bid);
    pg8::gemm_phase<Epi, false>(C.lds, s, s, K / 64, K / 64, v, v, S, E, C.tid);
}

constexpr int PH_PER_LAYER = 10, N_PHASES = 1 + DEPTH * PH_PER_LAYER + 1;

__global__ void __launch_bounds__(512, 2) mega(Args args) {
    extern __shared__ __attribute__((aligned(16))) unsigned char lds_raw[];
    Ctx C;
    C.in = args.in; C.out = args.out; C.ws = args.ws; C.lds = (LAS unsigned char*)lds_raw;
    C.G = gridDim.x; C.bid = blockIdx.x;

    for (int ph = args.ph_lo; ph < args.ph_hi; ++ph) {
        { int t_ = threadIdx.x; asm volatile("" : "+v"(t_)); C.tid = t_; C.lane = t_ & 63; C.wave = __builtin_amdgcn_readfirstlane(t_ >> 6); }
        if (ph == 0) phase_p0(C);
        else if (ph == N_PHASES - 1) phase_final(C);
        else {
            const int l = (ph - 1) / PH_PER_LAYER, sp = (ph - 1) % PH_PER_LAYER;
            unsigned char* wt = C.ws + WS_WT;
            switch ((ONLY_SP >= 0) ? ONLY_SP : sp) {
            case 0: phase_prep(C, l); break;
            case 1: {
                EpiIn E{WSP(float, WS_ROWSS), WSP(float, WS_CIN), WSP(bf16_t, WS_GB), WSP(bf16_t, WS_V), WSP(bf16_t, WS_U), WSP(bf16_t, WS_SGA), WSP(bf16_t, WS_YB)};
                gemm_plain(C, WSP(bf16_t, WS_XS), (const bf16_t*)(wt + WT_IN), TR, DIN, D, E);
            } break;
            case 2: {
                pg8::Seg s; s.A = (const char*)WSP(bf16_t, WS_U); s.B = (const char*)WSP(bf16_t, WS_WG);
                s.tA = 256 * 1024 * 2; s.gA = UROWS * 16 * 2; s.hA = 128 * 1024 * 2; s.kA = 128;
                s.tB = 0; s.gB = 256 * 1024 * 2; s.hB = 128 * 1024 * 2; s.kB = 128;
                const pg8::Voff v = pg8::voff_plain(C.tid, 2048, 2048);
                pg8::Order S; S.init(3, 1, NG, C.G, C.bid);
                EpiSloc E{WSP(float, WS_SLOC)};
                pg8::gemm_phase<EpiSloc, false>(C.lds, s, s, 16, 16, v, v, S, E, C.tid);
                phase_conv(C, l);
            } break;
            case 3: phase_scan(C, l); break;
            case 4: {
                pg8::Seg s0, s1;
                s0.A = (const char*)WSP(bf16_t, WS_U); s0.tA = 256 * 1024 * 2; s0.gA = UROWS * 16 * 2; s0.hA = 128 * 1024 * 2; s0.kA = 128;
                s0.B = (const char*)WSP(bf16_t, WS_KC) + 2 * 63 * 256 - 1536; s0.tB = 8192; s0.gB = 127 * 256 * 2; s0.hB = 4096; s0.kB = -2048;
                s1.A = (const char*)WSP(bf16_t, WS_SIN); s1.tA = 256 * 256 * 2; s1.gA = NCHP * 256 * 2; s1.hA = 128 * 256 * 2; s1.kA = 128;
                s1.B = (const char*)WSP(bf16_t, WS_MG); s1.tB = 256 * 256 * 2; s1.gB = 1024 * 256 * 2; s1.hB = 128 * 256 * 2; s1.kB = 128;
                pg8::Voff v0 = pg8::voff_plain(C.tid, 2048, 32), v1 = pg8::voff_plain(C.tid, 512, 512);
                {
                    int R, Cc; pg8::stage_rc(C.tid * 16, R, Cc); int Rb = (R & ~31) + pg8::perm32(R & 31);
                    v0.b0 = (unsigned)(Rb * 32 - (Cc >> 4) * 512 + (Cc & 15) * 2 + 1536);
                    pg8::stage_rc(C.tid * 16 + 8192, R, Cc); Rb = (R & ~31) + pg8::perm32(R & 31);
                    v0.b1 = (unsigned)(Rb * 32 - (Cc >> 4) * 512 + (Cc & 15) * 2 + 1536);
                }
                pg8::Order S; S.init(3, 4, NG, C.G, C.bid);
                EpiSsm E{WSP(bf16_t, WS_U), C.in[19] + (size_t)l * DS, WSP(bf16_t, WS_S)};
                pg8::gemm_phase<EpiSsm, true>(C.lds, s0, s1, 16, 20, v0, v1, S, E, C.tid);
            } break;
            case 5: {
                EpiGlu E{C.in[21] + (size_t)l * 2048, WSP(bf16_t, WS_YB)};
                gemm_plain(C, WSP(bf16_t, WS_S), (const bf16_t*)(wt + WT_GLU), TR, 2048, DS, E);
            } break;
            case 6: {
                EpiMerge E{WSP(bf16_t, WS_SGA), WSP(bf16_t, WS_YB)};
                gemm_plain(C, WSP(bf16_t, WS_GB), (const bf16_t*)(wt + WT_OUTA), TR, D, DC, E);
            } break;
            case 7: {
                const float* gsv = WSP(float, WS_GSV) + (size_t)l * 4 * 3 * D;
                EpiRes E{C.out, WSP(float, WS_CTXX), gsv + 2 * 3 * D, gsv + 1 * 3 * D, WSP(bf16_t, WS_XS), WSP(float, WS_ROWSS), 1};
                gemm_plain(C, WSP(bf16_t, WS_YB), (const bf16_t*)(wt + WT_O), TR, D, D, E);
            } break;
            case 8: {
                EpiFf E{WSP(float, WS_ROWSS), WSP(float, WS_CFF), WSP(bf16_t, WS_HID)};
                gemm_plain(C, WSP(bf16_t, WS_XS), (const bf16_t*)(wt + WT_FFIN), TR, 2 * DFF, D, E);
            } break;
            case 9: {
                const int ln = l + 1 < DEPTH ? l + 1 : l;
                const float* gsv = WSP(float, WS_GSV);
                EpiRes E{C.out, WSP(float, WS_CTXX), gsv + ((size_t)l * 4 + 3) * 3 * D, gsv + ((size_t)ln * 4 + 0) * 3 * D, WSP(bf16_t, WS_XS), WSP(float, WS_ROWSS), l + 1 < DEPTH ? 1 : 0};
                gemm_plain(C, WSP(bf16_t, WS_HID), (const bf16_t*)(wt + WT_FFOUT), TR, D, DFF, E);
            } break;
            }
        }
        if (ph + 1 < args.ph_hi) {
            if (args.coop) cg::this_grid().sync();
        }
    }
}

extern "C" void kernel_launch(void* const* d_in, const int* in_sizes, int n_in, void* d_out, int out_size, void* d_ws, size_t ws_size, hipStream_t stream) {
    static int grid = 0;
    if (grid == 0) {
        if (n_in != 26 || out_size != NLAT * D || ws_size < WS_END) { fprintf(stderr, "kernel_launch: unexpected shapes (n_in %d out %d ws %zu need %zu)\n", n_in, out_size, ws_size, (size_t)WS_END); grid = -1; return; }
        if (hipFuncSetAttribute((const void*)mega, hipFuncAttributeMaxDynamicSharedMemorySize, LDS_BYTES) != hipSuccess) { fprintf(stderr, "hipFuncSetAttribute failed\n"); grid = -1; return; }
        int dev = 0, cus = 0, per_cu = 0;
        hipGetDevice(&dev); hipDeviceGetAttribute(&cus, hipDeviceAttributeMultiprocessorCount, dev);
        hipOccupancyMaxActiveBlocksPerMultiprocessor(&per_cu, (const void*)mega, 512, LDS_BYTES);
        (void)hipGetLastError();
        if (per_cu < 1) fprintf(stderr, "occupancy query says %d blocks per CU\n", per_cu);
        grid = cus > 0 ? cus : 256;
    }
    if (grid < 0) return;
    Args a{};
    for (int i = 0; i < 26; ++i) a.in[i] = (const float*)d_in[i];
    a.out = (float*)d_out; a.ws = (unsigned char*)d_ws; a.pad = 0;
#if MK_COOP
    a.ph_lo = 0; a.ph_hi = N_PHASES; a.coop = 1;
    void* kargs[] = {&a};
    hipError_t e = hipLaunchCooperativeKernel((const void*)mega, dim3(grid), dim3(512), kargs, LDS_BYTES, stream);
    if (e != hipSuccess) fprintf(stderr, "cooperative launch failed: %s (grid %d)\n", hipGetErrorString(e), grid);
#else
    for (int ph = 0; ph < N_PHASES; ++ph) {
        a.ph_lo = ph; a.ph_hi = ph + 1; a.coop = 0;
        hipLaunchKernelGGL(mega, dim3(grid), dim3(512), LDS_BYTES, stream, a);
    }
#endif
}
```

```cpp
#include <hip/hip_runtime.h>
#include <hip/hip_cooperative_groups.h>
#include <cstdio>
#include <cstdint>
namespace cg = cooperative_groups;

#ifndef PROBE_EMPTY
#define PROBE_EMPTY 0
#endif
#ifndef EPI_FENCE
#define EPI_FENCE
#endif
#ifndef ONLY_SP
#define ONLY_SP -1
#endif
#ifndef PROBE_SP
#define PROBE_SP -2
#endif
#define PROBE_REP 4
#ifndef MK_COOP
#define MK_COOP 1
#endif

#define LAS __attribute__((address_space(3)))
typedef unsigned short bf16_t;
typedef short bf16x8 __attribute__((ext_vector_type(8)));
typedef float f32x4 __attribute__((ext_vector_type(4)));
typedef unsigned u32x4 __attribute__((ext_vector_type(4)));

constexpr int D = 1024, SEQ = 16384, NLAT = 32768, CTXL = 256, NCTX = 512, TR = NLAT + NCTX  ;
constexpr int DEPTH = 4, DC = 512, DS = 512, NG = 32, NP = 64, DFF = 2816, DIN = 4096;
constexpr int NCH = TR / 64  , NCHP = 768, UROWS = NCHP * 64;
constexpr float RMS_EPS = 1e-6f;

constexpr size_t al(size_t x) { return (x + 4095) & ~(size_t)4095; }
constexpr size_t WS_BAR = 0;
constexpr size_t WS_ROWSS = 16384;
constexpr size_t WS_MOD = al(WS_ROWSS + (size_t)TR * 16 * 4);
constexpr size_t WS_GSV = al(WS_MOD + (size_t)4 * 3 * 6144 * 4);
constexpr size_t WS_CIN = al(WS_GSV + (size_t)4 * 4 * 3 * 1024 * 4);
constexpr size_t WS_CFF = al(WS_CIN + (size_t)3 * 4096 * 4);
constexpr size_t WS_APOW = al(WS_CFF + (size_t)3 * 5632 * 4);
constexpr size_t WS_BBAR = al(WS_APOW + (size_t)4 * 2 * 32 * 65 * 64 * 2 * 4);
constexpr size_t WS_KC = al(WS_BBAR + (size_t)4 * 2 * 32 * 64 * 16 * 2 * 4);
constexpr size_t WS_WG = al(WS_KC + (size_t)32 * 127 * 256 * 2 + 8192);
constexpr size_t WS_MG = al(WS_WG + (size_t)32 * 256 * 1024 * 2);
constexpr size_t WS_SLOC = al(WS_MG + (size_t)32 * 1024 * 256 * 2);
constexpr size_t WS_SIN = al(WS_SLOC + (size_t)32 * NCHP * 256 * 4);
constexpr size_t WS_CTXX = al(WS_SIN + (size_t)32 * NCHP * 256 * 2);
constexpr size_t WS_WT = al(WS_CTXX + (size_t)NCTX * D * 4);
constexpr size_t WT_IN = 0, WT_OUTA = WT_IN + (size_t)DIN * D * 2, WT_GLU = WT_OUTA + (size_t)D * DC * 2, WT_O = WT_GLU + (size_t)2048 * DS * 2,
                 WT_FFIN = WT_O + (size_t)D * D * 2, WT_FFOUT = WT_FFIN + (size_t)2 * DFF * D * 2, WT_END = WT_FFOUT + (size_t)D * DFF * 2;
constexpr size_t WS_XS = al(WS_WT + WT_END);
constexpr size_t WS_YB = al(WS_XS + (size_t)TR * D * 2);
constexpr size_t WS_GB = al(WS_YB + (size_t)TR * D * 2);
constexpr size_t WS_V = al(WS_GB + (size_t)TR * DC * 2);
constexpr size_t WS_U = al(WS_V + (size_t)TR * DC * 2);
constexpr size_t WS_S = al(WS_U + (size_t)NG * UROWS * 16 * 2);
constexpr size_t WS_SGA = al(WS_S + (size_t)TR * DS * 2);
constexpr size_t WS_OVL_END = al(WS_SGA + (size_t)TR * D * 2);
constexpr size_t WS_HID = WS_GB;
static_assert(WS_HID + (size_t)TR * DFF * 2 <= WS_OVL_END, "hid overlay");
constexpr size_t WS_END = WS_OVL_END;
static_assert(WS_END <= (size_t)512 * 1024 * 1024, "workspace");

constexpr int LDS_BYTES = 147456;

__device__ __forceinline__ unsigned f2bf(float f) { unsigned u = __builtin_bit_cast(unsigned, f); return (u + 0x7fffu + ((u >> 16) & 1u)) >> 16; }
__device__ __forceinline__ unsigned pk2(float lo, float hi) { return f2bf(lo) | (f2bf(hi) << 16); }
__device__ __forceinline__ float bflo(unsigned w) { return __builtin_bit_cast(float, w << 16); }
__device__ __forceinline__ float bfhi(unsigned w) { return __builtin_bit_cast(float, w & 0xffff0000u); }
__device__ __forceinline__ float sigm(float x) { return __builtin_amdgcn_rcpf(1.0f + __expf(-x)); }
__device__ __forceinline__ float wave_sum(float v) {
#pragma unroll
    for (int o = 1; o < 64; o <<= 1) v += __shfl_xor(v, o);
    return v;
}
__device__ __forceinline__ void sincos_cw(float x, float& s, float& c) {
    const float q = rintf(x * 0.63661977236758134f);
    float r = fmaf(-q, 1.5703125f, x);
    r = fmaf(-q, 4.837512969970703125e-4f, r);
    r = fmaf(-q, 7.54978995489188e-8f, r);
    const float r2 = r * r;
    float sp = fmaf(r2, 2.7557319e-6f, -1.9841270e-4f); sp = fmaf(sp, r2, 8.3333333e-3f); sp = fmaf(sp, r2, -1.6666667e-1f); sp = fmaf(sp * r2, r, r);
    float cp = fmaf(r2, -2.7557319e-7f, 2.4801587e-5f); cp = fmaf(cp, r2, -1.3888889e-3f); cp = fmaf(cp, r2, 4.1666667e-2f); cp = fmaf(cp, r2, -0.5f); cp = fmaf(cp, r2, 1.0f);
    const int qi = (int)q & 3;
    const float ss = (qi & 1) ? cp : sp, cc = (qi & 1) ? sp : cp;
    s = (qi & 2) ? -ss : ss; c = ((qi + 1) & 2) ? -cc : cc;
}


#define XB_TMO      128
#define XB_XCNT(j)  (256  + 64 * (j))
#define XB_XSUB(j)  (1280 + 64 * (j))
#define XB_XGEN(j)  (2304 + 64 * (j))
#define XB_TOP      3328
#define XB_TOPGEN   3392
#define XCD_BAR_WORDS 3456
#define XB_SPIN_CAP (1u << 18)
__device__ __forceinline__ unsigned xb_ld(unsigned* p)              { return __hip_atomic_load(p, __ATOMIC_RELAXED, __HIP_MEMORY_SCOPE_AGENT); }
__device__ __forceinline__ unsigned xb_add(unsigned* p, unsigned v) { return __hip_atomic_fetch_add(p, v, __ATOMIC_RELAXED, __HIP_MEMORY_SCOPE_AGENT); }
__device__ __forceinline__ unsigned xb_xcc_id() { return (unsigned)__builtin_amdgcn_s_getreg((3 << 11) | 20) & 0xFu; }
#define XB_SPIN(cond, bar) do { unsigned _sp = 0; while (cond) { __builtin_amdgcn_s_sleep(1); \
    if ((++_sp & 255u) == 0u) { if (xb_ld(&(bar)[XB_TMO])) break; if (_sp > XB_SPIN_CAP) { atomicAdd(&(bar)[XB_TMO], 1u); break; } } } } while (0)
struct XcdBarrier { unsigned* bar; unsigned x; volatile LAS unsigned* st; };
__device__ __forceinline__ XcdBarrier xcd_barrier_post(unsigned* bar, volatile LAS unsigned* st, int tid) {
    XcdBarrier b; b.bar = bar; b.x = xb_xcc_id(); b.st = st;
    if (tid == 0) (void)xb_add(&bar[XB_XCNT(b.x)], 1u);
    return b;
}
__device__ __forceinline__ void xcd_barrier_complete(unsigned* bar, unsigned x, unsigned& nloc, unsigned& nx) {
    const unsigned G = gridDim.x * gridDim.y * gridDim.z;
    unsigned sum, cnt, mine, sp = 0u;
    for (;;) {
        sum = 0u; cnt = 0u; mine = 0u;
#pragma unroll
        for (unsigned j = 0; j < 16; ++j) { const unsigned c = xb_ld(&bar[XB_XCNT(j)]); sum += c; cnt += (c > 0u) ? 1u : 0u; mine = (j == x) ? c : mine; }
        if (sum == G) break;
        __builtin_amdgcn_s_sleep(1);
        if ((++sp & 255u) == 0u) { if (xb_ld(&bar[XB_TMO])) break; if (sp > XB_SPIN_CAP) { atomicAdd(&bar[XB_TMO], 1u); break; } }
    }
    nloc = mine > 0u ? mine : 1u; nx = cnt > 0u ? cnt : 1u;
}
__device__ __forceinline__ void xcd_barrier(const XcdBarrier& b, int tid) {
    asm volatile("s_waitcnt vmcnt(0)" ::: "memory");
    __syncthreads();
    if (tid == 0) {
        unsigned* bar = b.bar;
        __builtin_amdgcn_s_waitcnt(0);
        unsigned nloc = b.st[0], nx = b.st[1];
        if (nloc == 0u) { xcd_barrier_complete(bar, b.x, nloc, nx); b.st[0] = nloc; b.st[1] = nx; }
        const unsigned old = xb_add(&bar[XB_XSUB(b.x)], 1u);
        const unsigned gen = old / nloc;
        if (old + 1u == (gen + 1u) * nloc) {
            __builtin_amdgcn_fence(__ATOMIC_RELEASE, "agent");
            asm volatile("s_waitcnt vmcnt(0)" ::: "memory");
            const unsigned og = xb_add(&bar[XB_TOP], 1u);
            const unsigned tg = og / nx;
            if (og + 1u == (tg + 1u) * nx) xb_add(&bar[XB_TOPGEN], 1u);
            else XB_SPIN(xb_ld(&bar[XB_TOPGEN]) == tg, bar);
            __builtin_amdgcn_fence(__ATOMIC_ACQUIRE, "agent");
            xb_add(&bar[XB_XGEN(b.x)], 1u);
            asm volatile("s_waitcnt vmcnt(0)" ::: "memory");
        } else {
            XB_SPIN(xb_ld(&bar[XB_XGEN(b.x)]) == gen, bar);
            __builtin_amdgcn_fence(__ATOMIC_ACQUIRE, "agent");
            asm volatile("s_waitcnt vmcnt(0)" ::: "memory");
        }
    }
    __syncthreads();
}

namespace pg8 {
constexpr int BM = 256, BK = 64, HALF = 128, HTB = HALF * BK * 2, STAGE_BYTES = 8 * HTB, NXCD = 8, WGM = 8;
__host__ __device__ __forceinline__ int lds_byte(int r, int c) { const int st = (r >> 4) * 2 + (c >> 5), rr = r & 15, cc = c & 31, ob = rr * 64 + cc * 2; return st * 1024 + (ob ^ (((ob >> 9) & 1) << 5)); }
__host__ __device__ __forceinline__ void stage_rc(int b, int& R, int& C) { const int st = b / 1024, sb = b % 1024, swz = sb ^ (((sb >> 9) & 1) << 5); R = (st >> 1) * 16 + swz / 64; C = (st & 1) * 32 + (swz % 64) / 2; }
__host__ __device__ __forceinline__ int perm32(int rho) { const int n = rho >> 4, i = rho & 15; return 8 * (i >> 2) + 4 * n + (i & 3); }

struct Unit { int pm, pn, g; };
struct Seg { const char* A; const char* B; int tA, tB, gA, gB, hA, hB, kA, kB; };

struct Order {
    int nM, nN, nwg, G, c, grouped;
    __device__ void init(int nM_, int nN_, int nG_, int G_, int c_) { nM = nM_; nN = nN_; grouped = nG_ > 1; nwg = nM * nN * nG_; G = G_; c = c_; }
    __device__ bool next(int i, Unit& u) const {
        const long L = (long)i * G + c; if (L >= nwg) return false;
        if (grouped) { const int per = nM * nN; u.g = (int)L / per; const int r = (int)L % per; u.pm = r % nM; u.pn = r / nM; return true; }
        int wgid = (int)L; { const int q = nwg / NXCD, r = nwg % NXCD, xcd = wgid % NXCD, off = wgid / NXCD; wgid = (xcd < r ? xcd * (q + 1) : r * (q + 1) + (xcd - r) * q) + off; }
        const int nig = WGM * nN, gid = wgid / nig, fm = gid * WGM, gsz = (nM - fm) < WGM ? (nM - fm) : WGM;
        u.pm = fm + ((wgid % nig) % gsz); u.pn = (wgid % nig) / gsz; u.g = 0; return true;
    }
};

struct Voff { unsigned a0, a1, b0, b1; };
__device__ __forceinline__ Voff voff_plain(int tid, int ldaB, int ldbB) {
    Voff v; int R, C;
    stage_rc(tid * 16, R, C); { const int Rb = (R & ~31) + perm32(R & 31); v.a0 = (unsigned)(R * ldaB + C * 2); v.b0 = (unsigned)(Rb * ldbB + C * 2); }
    stage_rc(tid * 16 + 8192, R, C); { const int Rb = (R & ~31) + perm32(R & 31); v.a1 = (unsigned)(R * ldaB + C * 2); v.b1 = (unsigned)(Rb * ldbB + C * 2); }
    return v;
}

#define EPI_ARGS const f32x4 (&acc)[2][2][4][2], const pg8::Unit& u, int wr, int wc, int fr, int fq

template <class Epi, bool TWOSEG>
__device__ __forceinline__ void gemm_phase(LAS unsigned char* lds, const Seg s0, const Seg s1, const int nt0, const int nt_in, const Voff v0_in, const Voff v1_in, const Order& S, const Epi& E, const int tid) {
    int nt = nt_in; asm volatile("" : "+s"(nt));
    const int wid = __builtin_amdgcn_readfirstlane(tid >> 6), lane = tid & 63, wr = wid >> 2, wc = wid & 3, fr = lane & 15, fq = lane >> 4;
    const unsigned ldsw = (unsigned)wid * 1024u;
    const int aoff = lds_byte(wr * 64 + fr, fq * 8), boff = lds_byte(wc * 32 + fr, fq * 8);
#define PG8_SA(b, h) (((b) * 2 + (h)) * HTB)
#define PG8_SB(b, h) ((4 + (b) * 2 + (h)) * HTB)
#define PG8_SEG1(t) (TWOSEG && (t) >= nt0)
#define PG8_UA(u, t) (PG8_SEG1(t) ? (s1.A + (long long)((u).g * s1.gA + (u).pm * s1.tA + ((t) - nt0) * s1.kA)) : (s0.A + (long long)((u).g * s0.gA + (u).pm * s0.tA + (t) * s0.kA)))
#define PG8_UB(u, t) (PG8_SEG1(t) ? (s1.B + (long long)((u).g * s1.gB + (u).pn * s1.tB + ((t) - nt0) * s1.kB)) : (s0.B + (long long)((u).g * s0.gB + (u).pn * s0.tB + (t) * s0.kB)))
#define PG8_HA(t) (PG8_SEG1(t) ? s1.hA : s0.hA)
#define PG8_HB(t) (PG8_SEG1(t) ? s1.hB : s0.hB)
#define PG8_STG(bufoff, gptr, o0, o1) do { \
        __builtin_amdgcn_global_load_lds((const unsigned*)((gptr) + (o0)), (LAS unsigned*)(lds + (bufoff) + ldsw), 16, 0, 0); \
        __builtin_amdgcn_global_load_lds((const unsigned*)((gptr) + (o1)), (LAS unsigned*)(lds + (bufoff) + ldsw + 8192), 16, 0, 0); } while (0)
#define PG8_STG_A(bufoff, gptr, t) do { const bool s_ = PG8_SEG1(t); PG8_STG(bufoff, gptr, s_ ? v1.a0 : v0.a0, s_ ? v1.a1 : v0.a1); } while (0)
#define PG8_STG_B(bufoff, gptr, t) do { const bool s_ = PG8_SEG1(t); PG8_STG(bufoff, gptr, s_ ? v1.b0 : v0.b0, s_ ? v1.b1 : v0.b1); } while (0)
#define PG8_LDA(dst, b, h) do { _Pragma("unroll") for (int m = 0; m < 4; ++m) _Pragma("unroll") for (int k = 0; k < 2; ++k) dst[m][k] = *(const LAS bf16x8*)(lds + PG8_SA(b, h) + aoff + m * 2048 + k * 1024); } while (0)
#define PG8_LDB(dst, b, h) do { _Pragma("unroll") for (int n = 0; n < 2; ++n) _Pragma("unroll") for (int k = 0; k < 2; ++k) dst[n][k] = *(const LAS bf16x8*)(lds + PG8_SB(b, h) + boff + n * 2048 + k * 1024); } while (0)
#define PG8_MMA(ai, bj, At, Bt) do { __builtin_amdgcn_s_setprio(1); _Pragma("unroll") for (int m = 0; m < 4; ++m) _Pragma("unroll") for (int n = 0; n < 2; ++n) _Pragma("unroll") for (int k = 0; k < 2; ++k) \
        acc[ai][bj][m][n] = __builtin_amdgcn_mfma_f32_16x16x32_bf16(Bt[n][k], At[m][k], acc[ai][bj][m][n], 0, 0, 0); __builtin_amdgcn_s_setprio(0); } while (0)
#define PG8_WAIT_V(n) asm volatile("s_waitcnt vmcnt(" #n ")" ::: "memory")
#define PG8_WAIT_L(n) asm volatile("s_waitcnt lgkmcnt(" #n ")" ::: "memory")
#define PG8_BAR __builtin_amdgcn_s_barrier()
#define PG8_SCHED __builtin_amdgcn_sched_barrier(0)
    Unit cur, nxt; int ui = 0;
    if (!S.next(0, cur)) return;
    f32x4 acc[2][2][4][2];
#pragma unroll
    for (int a = 0; a < 2; ++a)
#pragma unroll
        for (int b = 0; b < 2; ++b)
#pragma unroll
            for (int m = 0; m < 4; ++m)
#pragma unroll
                for (int n = 0; n < 2; ++n) acc[a][b][m][n] = (f32x4){0.f, 0.f, 0.f, 0.f};
    bf16x8 At[4][2], B0[2][2], B1[2][2];
    Voff v0 = v0_in, v1 = v1_in;
    asm volatile("" : "+v"(v0.a0), "+v"(v0.a1), "+v"(v0.b0), "+v"(v0.b1));
    if (TWOSEG) asm volatile("" : "+v"(v1.a0), "+v"(v1.a1), "+v"(v1.b0), "+v"(v1.b1));
    {
        const char* cA0 = PG8_UA(cur, 0); const char* cB0 = PG8_UB(cur, 0); const char* cA1 = PG8_UA(cur, 1); const char* cB1 = PG8_UB(cur, 1);
        PG8_STG_B(PG8_SB(0, 0), cB0, 0); PG8_STG_A(PG8_SA(0, 0), cA0, 0); PG8_STG_B(PG8_SB(0, 1), cB0 + PG8_HB(0), 0); PG8_STG_A(PG8_SA(0, 1), cA0 + PG8_HA(0), 0);
        if (wr == 1) PG8_BAR;
        PG8_WAIT_V(4); PG8_BAR;
        PG8_STG_B(PG8_SB(1, 0), cB1, 1); PG8_STG_A(PG8_SA(1, 0), cA1, 1); PG8_STG_B(PG8_SB(1, 1), cB1 + PG8_HB(1), 1);
        PG8_WAIT_V(6); PG8_BAR;
    }
    for (;;) {
        const bool has_next = S.next(ui + 1, nxt);
        Unit nu; nu.pm = has_next ? nxt.pm : cur.pm; nu.pn = has_next ? nxt.pn : cur.pn; nu.g = has_next ? nxt.g : cur.g;
#pragma clang loop unroll(disable)
        for (int t = 0; t < nt; t += 2) {
            const bool last = (t == nt - 2);
            const int t1 = t + 1, t2 = last ? 0 : t + 2, t3 = t2 + 1;
            Unit u2; u2.pm = last ? nu.pm : cur.pm; u2.pn = last ? nu.pn : cur.pn; u2.g = last ? nu.g : cur.g;
            const char* a1 = PG8_UA(cur, t1);
            const char* a2 = PG8_UA(u2, t2); const char* b2 = PG8_UB(u2, t2);
            const char* a3 = PG8_UA(u2, t3); const char* b3 = PG8_UB(u2, t3);
            PG8_LDB(B0, 0, 0); PG8_SCHED; PG8_LDA(At, 0, 0); PG8_STG_A(PG8_SA(1, 1), a1 + PG8_HA(t1), t1);
            PG8_WAIT_L(8); PG8_BAR; PG8_WAIT_L(0); PG8_MMA(0, 0, At, B0); PG8_BAR; PG8_SCHED;
            PG8_LDB(B1, 0, 1); PG8_STG_B(PG8_SB(0, 0), b2, t2);
            PG8_BAR; PG8_WAIT_L(0); PG8_MMA(0, 1, At, B1); PG8_BAR;
            PG8_LDA(At, 0, 1); PG8_STG_A(PG8_SA(0, 0), a2, t2);
            PG8_BAR; PG8_WAIT_L(0); PG8_MMA(1, 0, At, B0); PG8_BAR; PG8_SCHED;
            PG8_STG_B(PG8_SB(0, 1), b2 + PG8_HB(t2), t2);
            PG8_WAIT_V(6); PG8_BAR; PG8_MMA(1, 1, At, B1); PG8_BAR;
            PG8_LDB(B0, 1, 0); PG8_SCHED; PG8_LDA(At, 1, 0); PG8_STG_A(PG8_SA(0, 1), a2 + PG8_HA(t2), t2);
            PG8_WAIT_L(8); PG8_BAR; PG8_WAIT_L(0); PG8_MMA(0, 0, At, B0); PG8_BAR; PG8_SCHED;
            PG8_LDB(B1, 1, 1); PG8_STG_B(PG8_SB(1, 0), b3, t3);
            PG8_BAR; PG8_WAIT_L(0); PG8_MMA(0, 1, At, B1); PG8_BAR;
            PG8_LDA(At, 1, 1); PG8_STG_A(PG8_SA(1, 0), a3, t3);
            PG8_BAR; PG8_WAIT_L(0); PG8_MMA(1, 0, At, B0); PG8_BAR; PG8_SCHED;
            PG8_STG_B(PG8_SB(1, 1), b3 + PG8_HB(t3), t3);
            PG8_WAIT_V(6); PG8_BAR; PG8_MMA(1, 1, At, B1); PG8_BAR;
        }
        E(acc, cur, wr, wc, fr, fq);
        if (!has_next) break;
#pragma unroll
        for (int a = 0; a < 2; ++a)
#pragma unroll
            for (int b = 0; b < 2; ++b)
#pragma unroll
                for (int m = 0; m < 4; ++m)
#pragma unroll
                    for (int n = 0; n < 2; ++n) acc[a][b][m][n] = (f32x4){0.f, 0.f, 0.f, 0.f};
        cur = nxt; ++ui;
    }
    PG8_WAIT_V(0);
    if (wr == 0) PG8_BAR;
    PG8_BAR;
#undef PG8_SA
#undef PG8_SB
#undef PG8_SEG1
#undef PG8_UA
#undef PG8_UB
#undef PG8_HA
#undef PG8_HB
#undef PG8_STG
#undef PG8_STG_A
#undef PG8_STG_B
#undef PG8_LDA
#undef PG8_LDB
#undef PG8_MMA
#undef PG8_WAIT_V
#undef PG8_WAIT_L
#undef PG8_BAR
#undef PG8_SCHED
}
}

struct Args { const float* in[26]; float* out; unsigned char* ws; int ph_lo, ph_hi, coop, pad; };

struct Ctx {
    const float* const* in; float* out; unsigned char* ws; LAS unsigned char* lds;
    int tid, lane, wave, G, bid;
};
#define WSP(T, off) ((T*)(C.ws + (off)))
__device__ __forceinline__ int sid_of_pm(int pm) { return pm < 64 ? 0 : (pm < 128 ? 1 : 2); }
__device__ __forceinline__ int sid_of_row(int r) { return r < SEQ ? 0 : (r < NLAT ? 1 : 2); }

struct F8 { f32x4 lo, hi; };
__device__ __forceinline__ F8 ld8(const float* p) { F8 r; r.lo = *(const f32x4*)p; r.hi = *(const f32x4*)(p + 4); return r; }
__device__ __forceinline__ void st8bf(bf16_t* p, const float (&v)[8]) { u32x4 w; w.x = pk2(v[0], v[1]); w.y = pk2(v[2], v[3]); w.z = pk2(v[4], v[5]); w.w = pk2(v[6], v[7]); *(u32x4*)p = w; }
__device__ __forceinline__ void ld8bf(const bf16_t* p, float (&v)[8]) { const u32x4 w = *(const u32x4*)p; v[0] = bflo(w.x); v[1] = bfhi(w.x); v[2] = bflo(w.y); v[3] = bfhi(w.y); v[4] = bflo(w.z); v[5] = bfhi(w.z); v[6] = bflo(w.w); v[7] = bfhi(w.w); }
#define ACC8(dst, ai, bj, m) do { _Pragma("unroll") for (int j_ = 0; j_ < 4; ++j_) { dst[j_] = acc[ai][bj][m][0][j_]; dst[4 + j_] = acc[ai][bj][m][1][j_]; } } while (0)
#define F8ARR(dst, f) do { _Pragma("unroll") for (int j_ = 0; j_ < 4; ++j_) { dst[j_] = (f).lo[j_]; dst[4 + j_] = (f).hi[j_]; } } while (0)
__device__ __forceinline__ float rstd_of(const float* rowss, int row) {
    const f32x4* p = (const f32x4*)(rowss + (size_t)row * 16); const f32x4 a = p[0], b = p[1], c = p[2], d = p[3];
    const float s = ((a[0] + a[1]) + (a[2] + a[3])) + ((b[0] + b[1]) + (b[2] + b[3])) + ((c[0] + c[1]) + (c[2] + c[3])) + ((d[0] + d[1]) + (d[2] + d[3]));
    return rsqrtf(s * (1.0f / 1024.0f) + RMS_EPS);
}

struct EpiIn {
    const float* rowss; const float* cin; bf16_t *gb, *v, *uu, *sga, *sgb;
    __device__ __forceinline__ void operator()(EPI_ARGS) const {
        const int sid = sid_of_pm(u.pm), lc = wc * 32 + 8 * fq, pn = u.pn;
        float c0[8], c1[8];
        { const F8 a = ld8(cin + sid * DIN + pn * 256 + lc), b = ld8(cin + sid * DIN + pn * 256 + 128 + lc); F8ARR(c0, a); F8ARR(c1, b); }
#pragma unroll
        for (int ai = 0; ai < 2; ++ai)
#pragma unroll
            for (int m = 0; m < 4; ++m) {
                const int row = u.pm * 256 + ai * 128 + wr * 64 + m * 16 + fr;
                const float rs = rstd_of(rowss, row);
                float z0[8], z1[8]; ACC8(z0, ai, 0, m); ACC8(z1, ai, 1, m);
#pragma unroll
                for (int j = 0; j < 8; ++j) { z0[j] = fmaf(rs, z0[j], c0[j]); z1[j] = fmaf(rs, z1[j], c1[j]); }
                if (pn < 2) { st8bf(gb + (size_t)row * DC + pn * 256 + lc, z0); st8bf(gb + (size_t)row * DC + pn * 256 + 128 + lc, z1); }
                else if (pn < 6) {
#pragma unroll
                    for (int j = 0; j < 8; ++j) z0[j] *= z1[j];
                    st8bf(v + (size_t)row * DC + (pn - 2) * 128 + lc, z0); }
                else if (pn < 8) {
                    const int col0 = (pn - 6) * 256 + lc, col1 = col0 + 128;
                    st8bf(uu + ((size_t)(col0 >> 4) * UROWS + row) * 16 + (col0 & 8), z0);
                    st8bf(uu + ((size_t)(col1 >> 4) * UROWS + row) * 16 + (col1 & 8), z1); }
                else {
#pragma unroll
                    for (int j = 0; j < 8; ++j) { z0[j] = sigm(z0[j]); z1[j] = sigm(z1[j]); }
                    bf16_t* dst = (pn < 12) ? (sga + (size_t)row * D + (pn - 8) * 256 + lc) : (sgb + (size_t)row * D + (pn - 12) * 256 + lc);
                    st8bf(dst, z0); st8bf(dst + 128, z1); }
                EPI_FENCE;
            }
    }
};
struct EpiSloc {
    float* sloc;
    __device__ __forceinline__ void operator()(EPI_ARGS) const {
        const int lc = wc * 32 + 8 * fq;
#pragma unroll
        for (int ai = 0; ai < 2; ++ai)
#pragma unroll
            for (int m = 0; m < 4; ++m) {
                const int ch = u.pm * 256 + ai * 128 + wr * 64 + m * 16 + fr;
                if (ch < NCH) {
                    float* dst = sloc + ((size_t)u.g * NCHP + ch) * 256 + lc;
                    *(f32x4*)(dst) = acc[ai][0][m][0]; *(f32x4*)(dst + 4) = acc[ai][0][m][1];
                    *(f32x4*)(dst + 128) = acc[ai][1][m][0]; *(f32x4*)(dst + 132) = acc[ai][1][m][1]; }
                EPI_FENCE;
            }
    }
};
struct EpiSsm {
    const bf16_t* uu; const float* dskip; bf16_t* s;
    __device__ __forceinline__ void operator()(EPI_ARGS) const {
        const int lc = wc * 32 + 8 * fq;
#pragma unroll
        for (int bj = 0; bj < 2; ++bj) {
            const int n = u.pn * 256 + bj * 128 + lc, t = n >> 4, hh = n & 8;
            float dk[8]; { const F8 a = ld8(dskip + u.g * 16 + hh); F8ARR(dk, a); }
#pragma unroll
            for (int ai = 0; ai < 2; ++ai)
#pragma unroll
                for (int m = 0; m < 4; ++m) {
                    const int ch = u.pm * 256 + ai * 128 + wr * 64 + m * 16 + fr;
                    if (ch < NCH) {
                        const int tok = ch * 64 + t;
                        float y[8], uv[8]; ACC8(y, ai, bj, m); ld8bf(uu + ((size_t)u.g * UROWS + tok) * 16 + hh, uv);
#pragma unroll
                        for (int j = 0; j < 8; ++j) { const float x = fmaf(dk[j], uv[j], y[j]); y[j] = x * sigm(1.5957691216f * (x + 0.044715f * x * x * x)); }
                        st8bf(s + (size_t)tok * DS + u.g * 16 + hh, y); }
                    EPI_FENCE;
                }
        }
    }
};
struct EpiGlu {
    const float* bglu; bf16_t* yb;
    __device__ __forceinline__ void operator()(EPI_ARGS) const {
        const int lc = wc * 32 + 8 * fq, col = u.pn * 128 + lc;
        float bv[8], bg[8]; { const F8 a = ld8(bglu + col), b = ld8(bglu + 1024 + col); F8ARR(bv, a); F8ARR(bg, b); }
#pragma unroll
        for (int ai = 0; ai < 2; ++ai)
#pragma unroll
            for (int m = 0; m < 4; ++m) {
                const int row = u.pm * 256 + ai * 128 + wr * 64 + m * 16 + fr;
                float vv[8], gg[8], sg[8]; ACC8(vv, ai, 0, m); ACC8(gg, ai, 1, m);
                bf16_t* p = yb + (size_t)row * D + col; ld8bf(p, sg);
#pragma unroll
                for (int j = 0; j < 8; ++j) vv[j] = sg[j] * (vv[j] + bv[j]) * sigm(gg[j] + bg[j]);
                st8bf(p, vv);
                EPI_FENCE;
            }
    }
};
struct EpiMerge {
    const bf16_t* sga; bf16_t* yb;
    __device__ __forceinline__ void operator()(EPI_ARGS) const {
        const int lc = wc * 32 + 8 * fq;
#pragma unroll
        for (int ai = 0; ai < 2; ++ai)
#pragma unroll
            for (int m = 0; m < 4; ++m) {
                const int row = u.pm * 256 + ai * 128 + wr * 64 + m * 16 + fr;
#pragma unroll
                for (int bj = 0; bj < 2; ++bj) {
                    const size_t o = (size_t)row * D + u.pn * 256 + bj * 128 + lc;
                    float ya[8], a[8], b[8]; ACC8(ya, ai, bj, m); ld8bf(sga + o, a); ld8bf(yb + o, b);
#pragma unroll
                    for (int j = 0; j < 8; ++j) ya[j] = fmaf(a[j], ya[j], b[j]);
                    st8bf(yb + o, ya); }
                EPI_FENCE;
            }
    }
};
struct EpiRes {
    float* xlat; float* xctx; const float* gate; const float* gsn; bf16_t* xs; float* rowss; int emit;
    __device__ __forceinline__ void operator()(EPI_ARGS) const {
        const int sid = sid_of_pm(u.pm), lc = wc * 32 + 8 * fq;
        float ss[2][4];
#pragma unroll
        for (int ai = 0; ai < 2; ++ai)
#pragma unroll
            for (int m = 0; m < 4; ++m) ss[ai][m] = 0.f;
#pragma unroll
        for (int bj = 0; bj < 2; ++bj) {
            const int col = u.pn * 256 + bj * 128 + lc;
            float gt[8], gs[8]; { const F8 a = ld8(gate + sid * D + col); F8ARR(gt, a); }
            if (emit) { const F8 b = ld8(gsn + sid * D + col); F8ARR(gs, b); } else {
#pragma unroll
                for (int j = 0; j < 8; ++j) gs[j] = 0.f; }
#pragma unroll
            for (int ai = 0; ai < 2; ++ai)
#pragma unroll
                for (int m = 0; m < 4; ++m) {
                    const int row = u.pm * 256 + ai * 128 + wr * 64 + m * 16 + fr;
                    float* xp = (row < NLAT ? xlat + (size_t)row * D : xctx + (size_t)(row - NLAT) * D) + col;
                    float y[8], x[8]; ACC8(y, ai, bj, m); { const F8 a = ld8(xp); F8ARR(x, a); }
                    float q = 0.f;
#pragma unroll
                    for (int j = 0; j < 8; ++j) { x[j] = fmaf(gt[j], y[j], x[j]); q = fmaf(x[j], x[j], q); }
                    *(f32x4*)xp = (f32x4){x[0], x[1], x[2], x[3]}; *(f32x4*)(xp + 4) = (f32x4){x[4], x[5], x[6], x[7]};
                    if (emit) {
#pragma unroll
                        for (int j = 0; j < 8; ++j) x[j] *= gs[j];
                        st8bf(xs + (size_t)row * D + col, x); }
                    ss[ai][m] += q;
                    EPI_FENCE;
                }
        }
        if (emit) {
#pragma unroll
            for (int ai = 0; ai < 2; ++ai)
#pragma unroll
                for (int m = 0; m < 4; ++m) {
                    float q = ss[ai][m]; q += __shfl_xor(q, 16); q += __shfl_xor(q, 32);
                    const int row = u.pm * 256 + ai * 128 + wr * 64 + m * 16 + fr;
                    if (fq == 0) rowss[(size_t)row * 16 + u.pn * 4 + wc] = q; }
        }
    }
};
struct EpiNone { float* sink; __device__ __forceinline__ void operator()(EPI_ARGS) const {
    float t = 0.f;
#pragma unroll
    for (int ai = 0; ai < 2; ++ai)
#pragma unroll
        for (int bj = 0; bj < 2; ++bj)
#pragma unroll
            for (int m = 0; m < 4; ++m)
#pragma unroll
                for (int n = 0; n < 2; ++n) t += (acc[ai][bj][m][n][0] + acc[ai][bj][m][n][1]) + (acc[ai][bj][m][n][2] + acc[ai][bj][m][n][3]);
    if (t == 1.2345678e33f) sink[u.pm + wr + wc + fr + fq] = t; } };
struct EpiFf {
    const float* rowss; const float* cff; bf16_t* hid;
    __device__ __forceinline__ void operator()(EPI_ARGS) const {
        const int sid = sid_of_pm(u.pm), lc = wc * 32 + 8 * fq;
        float c0[8], c1[8];
        { const F8 a = ld8(cff + sid * 2 * DFF + u.pn * 256 + lc), b = ld8(cff + sid * 2 * DFF + u.pn * 256 + 128 + lc); F8ARR(c0, a); F8ARR(c1, b); }
#pragma unroll
        for (int ai = 0; ai < 2; ++ai)
#pragma unroll
            for (int m = 0; m < 4; ++m) {
                const int row = u.pm * 256 + ai * 128 + wr * 64 + m * 16 + fr;
                const float rs = rstd_of(rowss, row);
                float g[8], uu[8]; ACC8(g, ai, 0, m); ACC8(uu, ai, 1, m);
#pragma unroll
                for (int j = 0; j < 8; ++j) { const float gg = fmaf(rs, g[j], c0[j]), uv = fmaf(rs, uu[j], c1[j]); g[j] = gg * sigm(gg) * uv; }
                st8bf(hid + (size_t)row * DFF + u.pn * 128 + lc, g);
                EPI_FENCE;
            }
    }
};

template <int MAP  >
__device__ __forceinline__ int colmap(int v) {
    if (MAP == 1) { if (v >= 512 && v < 1536) { const int q = (v - 512) >> 8, r = (v - 512) & 255; return r < 128 ? 512 + 128 * q + r : 1024 + 128 * q + (r - 128); } return v; }
    if (MAP == 2) { const int q = v >> 8, r = v & 255; return r < 128 ? 128 * q + r : DFF + 128 * q + (r - 128); }
    return v;
}
template <int MAP>
__device__ __forceinline__ void gemv3_item(Ctx& C, int item, const float* W, int ldw, const LAS float* vecs, LAS float* red, const float* bias, float* out, int ostride) {
    const int vcol = item * 64 + C.lane, oc = colmap<MAP>(vcol);
    float a0 = 0.f, a1 = 0.f, a2 = 0.f;
    const int k0 = C.wave * 128;
#pragma unroll 1
    for (int kb = 0; kb < 4; ++kb) {
        float w[32];
#pragma unroll
        for (int i = 0; i < 32; ++i) w[i] = W[(size_t)(k0 + kb * 32 + i) * ldw + oc];
#pragma unroll
        for (int i = 0; i < 32; ++i) { const int k = k0 + kb * 32 + i; a0 = fmaf(vecs[k], w[i], a0); a1 = fmaf(vecs[1024 + k], w[i], a1); a2 = fmaf(vecs[2048 + k], w[i], a2); }
    }
    red[(C.wave * 3 + 0) * 64 + C.lane] = a0; red[(C.wave * 3 + 1) * 64 + C.lane] = a1; red[(C.wave * 3 + 2) * 64 + C.lane] = a2;
    __syncthreads();
    if (C.tid < 192) {
        const int s = C.tid >> 6, l = C.tid & 63; float r = 0.f;
#pragma unroll
        for (int w = 0; w < 8; ++w) r += red[(w * 3 + s) * 64 + l];
        const int vc = item * 64 + l, o2 = colmap<MAP>(vc);
        out[(size_t)s * ostride + vc] = r + (bias ? bias[o2] : 0.f);
    }
    __syncthreads();
}

template <int MAP  >
__device__ __forceinline__ int vrow_of(int n) {
    if (MAP == 1) { if (n >= 512 && n < 1024) { const int q = (n - 512) >> 7, r = (n - 512) & 127; return 512 + 256 * q + r; }
                    if (n >= 1024 && n < 1536) { const int q = (n - 1024) >> 7, r = (n - 1024) & 127; return 512 + 256 * q + 128 + r; } return n; }
    if (MAP == 2) { return n < 1024 ? 256 * (n >> 7) + (n & 127) : 256 * ((n - 1024) >> 7) + 128 + ((n - 1024) & 127); }
    if (MAP == 3) { return n < DFF ? 256 * (n >> 7) + (n & 127) : 256 * ((n - DFF) >> 7) + 128 + ((n - DFF) & 127); }
    return n;
}
template <int MAP>
__device__ __forceinline__ void transpose_item(const float* W, int K, int N, bf16_t* WT, LAS float* scr, int item, int lane) {
    const int nblk = N / 32, kb = item / nblk, nb = item % nblk, k0 = 64 * kb, n0 = 32 * nb;
#pragma unroll 8
    for (int i = 0; i < 32; ++i) { const int kk = 2 * i + (lane >> 5); scr[kk * 33 + (lane & 31)] = W[(size_t)(k0 + kk) * N + n0 + (lane & 31)]; }
    asm volatile("s_waitcnt lgkmcnt(0)" ::: "memory");
    const int c = lane & 7;
#pragma unroll
    for (int j = 0; j < 4; ++j) { const int n = (lane >> 3) + 8 * j; const LAS float* s = scr + (8 * c) * 33 + n;
        u32x4 o; o.x = pk2(s[0 * 33], s[1 * 33]); o.y = pk2(s[2 * 33], s[3 * 33]); o.z = pk2(s[4 * 33], s[5 * 33]); o.w = pk2(s[6 * 33], s[7 * 33]);
        *(u32x4*)(WT + (size_t)vrow_of<MAP>(n0 + n) * K + k0 + 8 * c) = o; }
    asm volatile("s_waitcnt lgkmcnt(0)" ::: "memory");
}

__device__ __forceinline__ void phase_p0(Ctx& C) {
    float* mod = WSP(float, WS_MOD);
    {
        LAS float* vecs = (LAS float*)C.lds; LAS float* red = vecs + 3072;
        for (int i = C.tid; i < 3072; i += 512) { const float x = i < 2048 ? C.in[1][i] : C.in[3][i - 2048]; vecs[i] = x * sigm(x); }
        __syncthreads();
        for (int it = C.bid; it < DEPTH * 96; it += C.G) {
            const int l = it / 96, item = it % 96;
            gemv3_item<0>(C, item, C.in[4] + (size_t)l * D * 6144, 6144, vecs, red, C.in[5] + (size_t)l * 6144, mod + (size_t)l * 3 * 6144, 6144);
        }
    }
    float* apow = WSP(float, WS_APOW); float* bbar = WSP(float, WS_BBAR);
    const int gt = C.bid * 512 + C.tid, GT = C.G * 512;
    for (int i = gt; i < DEPTH * 2 * NG * 65 * NP; i += GT) {
        const int p = i & 63, e = (i >> 6) % 65, ldg = (i >> 6) / 65;
        const float dt = expf(C.in[14][ldg]);
        const float lr = C.in[12][ldg * 64 + p], li = C.in[13][ldg * 64 + p];
        const float mag = expf((float)e * lr * dt); float s, c; sincos_cw((float)e * (li * dt), s, c);
        apow[(size_t)i * 2] = mag * c; apow[(size_t)i * 2 + 1] = mag * s;
    }
    for (int i = gt; i < DEPTH * 2 * NG * NP; i += GT) {
        const int ldg = i >> 6;
        const float dt = expf(C.in[14][ldg]);
        const float lr = C.in[12][i], li = C.in[13][i];
        const float mag = expf(lr * dt); float s, c; sincos_cw(li * dt, s, c);
        const float ar = mag * c, ai = mag * s, nr = ar - 1.0f, ni = ai, den = lr * lr + li * li;
        const float fr = (nr * lr + ni * li) / den, fi = (ni * lr - nr * li) / den;
        const float* br = C.in[15] + (size_t)i * 16; const float* bi = C.in[16] + (size_t)i * 16;
#pragma unroll
        for (int h = 0; h < 16; ++h) { const float x = br[h], y = bi[h]; bbar[((size_t)i * 16 + h) * 2] = fr * x - fi * y; bbar[((size_t)i * 16 + h) * 2 + 1] = fr * y + fi * x; }
    }
}

#ifndef PREP_PART
#define PREP_PART 15
#endif
__device__ __forceinline__ void phase_prep(Ctx& C, int l, int rep) {
    const int parts = rep ? PREP_PART : 15;
    if (parts & 1) {
        LAS float* scr = (LAS float*)(C.lds + 8192 + C.wave * 8448);
        unsigned char* wt = C.ws + WS_WT;
        const int gw = C.bid * 8 + C.wave, NGW = C.G * 8;
        constexpr int I0 = 16 * 128, I1 = 8 * 32, I2 = 8 * 64, I3 = 16 * 32, I4 = 16 * 176, I5 = 44 * 32;
        for (int it = gw; it < I0 + I1 + I2 + I3 + I4 + I5; it += NGW) {
            int r = it;
            if (r < I0) { transpose_item<1>(C.in[8] + (size_t)l * D * DIN, D, DIN, (bf16_t*)(wt + WT_IN), scr, r, C.lane); continue; } r -= I0;
            if (r < I1) { transpose_item<0>(C.in[11] + (size_t)l * DC * D, DC, D, (bf16_t*)(wt + WT_OUTA), scr, r, C.lane); continue; } r -= I1;
            if (r < I2) { transpose_item<2>(C.in[20] + (size_t)l * DS * 2048, DS, 2048, (bf16_t*)(wt + WT_GLU), scr, r, C.lane); continue; } r -= I2;
            if (r < I3) { transpose_item<0>(C.in[22] + (size_t)l * D * D, D, D, (bf16_t*)(wt + WT_O), scr, r, C.lane); continue; } r -= I3;
            if (r < I4) { transpose_item<3>(C.in[23] + (size_t)l * D * 2 * DFF, D, 2 * DFF, (bf16_t*)(wt + WT_FFIN), scr, r, C.lane); continue; } r -= I4;
            transpose_item<0>(C.in[24] + (size_t)l * DFF * D, DFF, D, (bf16_t*)(wt + WT_FFOUT), scr, r, C.lane);
        }
        __syncthreads();
    }
    const int gt = C.bid * 512 + C.tid, GT = C.G * 512;
    if (l == 0) {
        float* gsv = WSP(float, WS_GSV); const float* modall = WSP(float, WS_MOD);
        for (int i = gt; i < DEPTH * 4 * 3 * D; i += GT) {
            const int k = i & 1023, sid = (i >> 10) % 3, w = ((i >> 10) / 3) & 3, ll = (i >> 10) / 12;
            const float* mv = modall + ((size_t)ll * 3 + sid) * 6144;
            float r;
            if (w == 0) r = C.in[6][ll * D + k] * (1.0f + mv[1024 + k]);
            else if (w == 1) r = C.in[7][ll * D + k] * (1.0f + mv[4096 + k]);
            else if (w == 2) r = mv[2048 + k];
            else r = mv[5120 + k];
            gsv[i] = r;
        }
    }
    const float* apow = WSP(float, WS_APOW) + (size_t)l * 2 * NG * 65 * NP * 2;
    const float* bbar = WSP(float, WS_BBAR) + (size_t)l * 2 * NG * NP * 16 * 2;
    const float* cre = C.in[17] + (size_t)l * 2 * NG * 16 * NP; const float* cim = C.in[18] + (size_t)l * 2 * NG * 16 * NP;
    if (parts & 4) {
        bf16_t* kc = WSP(bf16_t, WS_KC);
        LAS float* Es = (LAS float*)C.lds;
        LAS float* Cs = Es + 2 * 4 * 16 * 132;
        for (int it = C.bid; it < NG * 16; it += C.G) {
            const int g = it >> 4, eg = it & 15;
#pragma unroll 4
            for (int i = 0; i < 16; ++i) {
                const int idx = C.tid + 512 * i, p = idx & 63, hi = (idx >> 6) & 15, e4 = (idx >> 10) & 3, dir = idx >> 12, e = eg * 4 + e4;
                const float* ap = apow + (((size_t)(dir * NG + g) * 65 + e) * NP + p) * 2; const float* bb = bbar + ((size_t)(dir * NG + g) * NP + p) * 32 + hi * 2;
                const float pr = ap[0], pi = ap[1], br = bb[0], bi = bb[1];
                Es[((dir * 4 + e4) * 16 + hi) * 132 + p * 2] = pr * br - pi * bi; Es[((dir * 4 + e4) * 16 + hi) * 132 + p * 2 + 1] = pr * bi + pi * br;
            }
#pragma unroll
            for (int i = 0; i < 4; ++i) {
                const int idx = C.tid + 512 * i, p = idx & 63, ho = (idx >> 6) & 15, dir = idx >> 10;
                Cs[(dir * 16 + ho) * 132 + p * 2] = cre[((size_t)(dir * NG + g) * 16 + ho) * NP + p]; Cs[(dir * 16 + ho) * 132 + p * 2 + 1] = cim[((size_t)(dir * NG + g) * 16 + ho) * NP + p];
            }
            __syncthreads();
#pragma unroll 1
            for (int i = 0; i < 4; ++i) {
                const int o = C.tid + 512 * i, hi = o & 15, ho = (o >> 4) & 15, e4 = (o >> 8) & 3, dir = o >> 10, e = eg * 4 + e4;
                float val = 0.f;
                const int nd = (e == 0 && dir == 0) ? 2 : 1;
                for (int dd2 = 0; dd2 < nd; ++dd2) {
                    const int d2 = dir + dd2;
                    const LAS f32x4* er = (const LAS f32x4*)(Es + ((d2 * 4 + e4) * 16 + hi) * 132); const LAS f32x4* cr4 = (const LAS f32x4*)(Cs + (d2 * 16 + ho) * 132);
#pragma unroll 8
                    for (int q = 0; q < 32; ++q) { const f32x4 ev = er[q], cv = cr4[q]; val += (cv[0] * ev[0] - cv[1] * ev[1]) + (cv[2] * ev[2] - cv[3] * ev[3]); }
                }
                if (!(e == 0 && dir == 1)) { const int dd = dir ? 63 - e : 63 + e; kc[((size_t)g * 127 + dd) * 256 + ho * 16 + hi] = (bf16_t)f2bf(val); }
            }
            __syncthreads();
        }
    }
    if (parts & 8) {
        bf16_t* wg = WSP(bf16_t, WS_WG);
        for (int i = gt; i < NG * 256 * 64; i += GT) {
            const int j = i & 63, n = (i >> 6) & 255, g = i >> 14, dir = n >> 7, ri = (n >> 6) & 1, p = n & 63, e = dir ? j : 63 - j;
            const float* ap = apow + (((size_t)(dir * NG + g) * 65 + e) * NP + p) * 2; const float pr = ap[0], pi = ap[1];
            const float* bb = bbar + ((size_t)(dir * NG + g) * NP + p) * 32;
            float o[16];
#pragma unroll
            for (int h = 0; h < 16; ++h) { const float br = bb[h * 2], bi = bb[h * 2 + 1]; o[h] = ri ? (pr * bi + pi * br) : (pr * br - pi * bi); }
            u32x4 w0, w1; w0.x = pk2(o[0], o[1]); w0.y = pk2(o[2], o[3]); w0.z = pk2(o[4], o[5]); w0.w = pk2(o[6], o[7]);
            w1.x = pk2(o[8], o[9]); w1.y = pk2(o[10], o[11]); w1.z = pk2(o[12], o[13]); w1.w = pk2(o[14], o[15]);
            u32x4* dst = (u32x4*)(wg + ((size_t)g * 256 + n) * 1024 + j * 16); dst[0] = w0; dst[1] = w1;
        }
    }
    if (parts & 8) {
        bf16_t* mg = WSP(bf16_t, WS_MG);
        for (int i = gt; i < NG * 1024 * 32; i += GT) {
            const int kc8 = i & 31, n = (i >> 5) & 1023, g = i >> 15, t = n >> 4, ho = n & 15, k0 = kc8 * 8, dir = k0 >> 7, ri = (k0 >> 6) & 1, p0 = k0 & 63, e = dir ? 64 - t : t + 1;
            const f32x4* ap4 = (const f32x4*)(apow + (((size_t)(dir * NG + g) * 65 + e) * NP + p0) * 2);
            const f32x4* cr4 = (const f32x4*)(cre + ((size_t)(dir * NG + g) * 16 + ho) * NP + p0); const f32x4* ci4 = (const f32x4*)(cim + ((size_t)(dir * NG + g) * 16 + ho) * NP + p0);
            const f32x4 a0 = ap4[0], a1 = ap4[1], a2 = ap4[2], a3 = ap4[3], c0 = cr4[0], c1 = cr4[1], d0 = ci4[0], d1 = ci4[1];
            const float prs[8] = {a0[0], a0[2], a1[0], a1[2], a2[0], a2[2], a3[0], a3[2]}, pis[8] = {a0[1], a0[3], a1[1], a1[3], a2[1], a2[3], a3[1], a3[3]};
            const float crs[8] = {c0[0], c0[1], c0[2], c0[3], c1[0], c1[1], c1[2], c1[3]}, cis[8] = {d0[0], d0[1], d0[2], d0[3], d1[0], d1[1], d1[2], d1[3]};
            float o[8];
#pragma unroll
            for (int q = 0; q < 8; ++q) o[q] = ri ? -(crs[q] * pis[q] + cis[q] * prs[q]) : (crs[q] * prs[q] - cis[q] * pis[q]);
            st8bf(mg + ((size_t)g * 1024 + n) * 256 + k0, o);
        }
    }
    if (l == 0) {
        const float* modall = WSP(float, WS_MOD);
        const int gw = C.bid * 8 + C.wave, NGW = C.G * 8;
        for (int row = gw; row < TR; row += NGW) {
            const int sid = sid_of_row(row);
            const float* src = row < NLAT ? C.in[0] + (size_t)row * D : C.in[2] + (size_t)(row - NLAT) * D;
            float* dst = row < NLAT ? C.out + (size_t)row * D : WSP(float, WS_CTXX) + (size_t)(row - NLAT) * D;
            bf16_t* xs = WSP(bf16_t, WS_XS) + (size_t)row * D;
            float q = 0.f;
#pragma unroll
            for (int j = 0; j < 4; ++j) {
                const int k = j * 256 + C.lane * 4;
                const f32x4 x = *(const f32x4*)(src + k), ng = *(const f32x4*)(C.in[6] + k), sc = *(const f32x4*)(modall + (size_t)sid * 6144 + 1024 + k);
                *(f32x4*)(dst + k) = x; q += (x[0] * x[0] + x[1] * x[1]) + (x[2] * x[2] + x[3] * x[3]);
                const unsigned w0 = pk2(x[0] * ng[0] * (1.f + sc[0]), x[1] * ng[1] * (1.f + sc[1])), w1 = pk2(x[2] * ng[2] * (1.f + sc[2]), x[3] * ng[3] * (1.f + sc[3]));
                *(unsigned long long*)(xs + k) = (unsigned long long)w0 | ((unsigned long long)w1 << 32);
            }
            q = wave_sum(q);
            if (C.lane < 16) WSP(float, WS_ROWSS)[(size_t)row * 16 + C.lane] = C.lane == 0 ? q : 0.f;
        }
    }
}

__device__ __forceinline__ void phase_prep_b(Ctx& C, int l) {
    const float* mod = WSP(float, WS_MOD) + (size_t)l * 3 * 6144;
    const int gw = C.bid * 8 + C.wave, NGW = C.G * 8;
#pragma unroll 1
    for (int which = 0; which < 2; ++which) {
        const int NV = which ? 2 * DFF : DIN;
        const bf16_t* wt = (const bf16_t*)(C.ws + WS_WT + (which ? WT_FFIN : WT_IN));
        const float* shb = mod + (which ? 3072 : 0);
        float sh[3][16];
#pragma unroll
        for (int sdx = 0; sdx < 3; ++sdx)
#pragma unroll
            for (int j = 0; j < 2; ++j) { const F8 a = ld8(shb + (size_t)sdx * 6144 + j * 512 + C.lane * 8); F8ARR((&sh[sdx][j * 8]), a); }
        float* out = which ? WSP(float, WS_CFF) : WSP(float, WS_CIN);
        for (int v = gw; v < NV; v += NGW) {
            float w0[8], w1[8]; ld8bf(wt + (size_t)v * D + C.lane * 8, w0); ld8bf(wt + (size_t)v * D + 512 + C.lane * 8, w1);
            float r0 = 0.f, r1 = 0.f, r2 = 0.f;
#pragma unroll
            for (int j = 0; j < 8; ++j) { r0 += sh[0][j] * w0[j] + sh[0][8 + j] * w1[j]; r1 += sh[1][j] * w0[j] + sh[1][8 + j] * w1[j]; r2 += sh[2][j] * w0[j] + sh[2][8 + j] * w1[j]; }
            r0 = wave_sum(r0); r1 = wave_sum(r1); r2 = wave_sum(r2);
            if (C.lane == 0) {
                const float bb = which ? 0.f : C.in[9][(size_t)l * DIN + colmap<1>(v)];
                out[v] = r0 + bb; out[NV + v] = r1 + bb; out[2 * NV + v] = r2 + bb; }
        }
    }
}

__device__ __forceinline__ void phase_conv(Ctx& C, int l) {
    const float* cw = C.in[10] + (size_t)l * 3 * DC;
    bf16_t* gb = WSP(bf16_t, WS_GB); const bf16_t* v = WSP(bf16_t, WS_V);
    const int gt = C.bid * 512 + C.tid, GT = C.G * 512;
    for (int i = gt; i < TR * 64; i += GT) {
        const int row = i >> 6, c8 = (i & 63) * 8;
        const bool lat = row < NLAT; const int pos = lat ? (row & 63) : ((row - NLAT) & 255), lastp = lat ? 63 : 255;
        float a[8], b[8], c[8], g[8], w0[8], w1[8], w2[8];
        ld8bf(v + (size_t)row * DC + c8, b);
        if (pos > 0) ld8bf(v + (size_t)(row - 1) * DC + c8, a); else {
#pragma unroll
            for (int j = 0; j < 8; ++j) a[j] = 0.f; }
        if (pos < lastp) ld8bf(v + (size_t)(row + 1) * DC + c8, c); else {
#pragma unroll
            for (int j = 0; j < 8; ++j) c[j] = 0.f; }
        ld8bf(gb + (size_t)row * DC + c8, g);
        { const F8 x = ld8(cw + c8), y = ld8(cw + DC + c8), z = ld8(cw + 2 * DC + c8); F8ARR(w0, x); F8ARR(w1, y); F8ARR(w2, z); }
#pragma unroll
        for (int j = 0; j < 8; ++j) g[j] *= (w0[j] * a[j] + w1[j] * b[j] + w2[j] * c[j]);
        st8bf(gb + (size_t)row * DC + c8, g);
    }
}

__device__ __forceinline__ void phase_scan(Ctx& C, int l) {
    LAS float* ag = (LAS float*)C.lds;
    for (int blk = C.bid; blk < 256; blk += C.G) {
        const int ci = blk * 32 + (C.tid & 31), seg = C.tid >> 5;
        const int p = ci & 63, g = (ci >> 6) & 31, dir = (ci >> 11) & 1, b = ci >> 12;
        const float* ap = WSP(float, WS_APOW) + ((((size_t)(l * 2 + dir) * NG + g) * 65 + 64) * NP + p) * 2;
        const float ar = ap[0], ai = ap[1];
        const float* sl = WSP(float, WS_SLOC) + (size_t)g * NCHP * 256 + dir * 128 + p;
        bf16_t* so = WSP(bf16_t, WS_SIN) + (size_t)g * NCHP * 256 + dir * 128 + p;
        float lr[16], li[16];
#pragma unroll
        for (int k = 0; k < 16; ++k) { const int kk = seg * 16 + k, ch = dir ? 256 * b + 255 - kk : 256 * b + kk; lr[k] = sl[(size_t)ch * 256]; li[k] = sl[(size_t)ch * 256 + 64]; }
        float xr = 0.f, xi = 0.f;
#pragma unroll
        for (int k = 0; k < 16; ++k) { const float nr = ar * xr - ai * xi + lr[k], ni = ar * xi + ai * xr + li[k]; xr = nr; xi = ni; }
        ag[((seg + 1) * 32 + (C.tid & 31)) * 2] = xr; ag[((seg + 1) * 32 + (C.tid & 31)) * 2 + 1] = xi;
        if (seg == 0) {
            float sr = 0.f, si = 0.f;
#pragma unroll
            for (int st = 0; st < 4; ++st) {
                const int ch = dir ? 512 + 4 * b + 3 - st : 512 + 4 * b + st;
                so[(size_t)ch * 256] = (bf16_t)f2bf(sr); so[(size_t)ch * 256 + 64] = (bf16_t)f2bf(si);
                const float cr = sl[(size_t)ch * 256], cim = sl[(size_t)ch * 256 + 64];
                const float nr = ar * sr - ai * si + cr, ni = ar * si + ai * sr + cim; sr = nr; si = ni;
            }
            ag[(C.tid & 31) * 2] = sr; ag[(C.tid & 31) * 2 + 1] = si;
        }
        __syncthreads();
        float a16r = ar, a16i = ai;
#pragma unroll
        for (int q = 0; q < 4; ++q) { const float nr = a16r * a16r - a16i * a16i, ni = 2.f * a16r * a16i; a16r = nr; a16i = ni; }
        float sr = ag[(C.tid & 31) * 2], si = ag[(C.tid & 31) * 2 + 1];
        for (int s2 = 0; s2 < seg; ++s2) {
            const float gr = ag[((s2 + 1) * 32 + (C.tid & 31)) * 2], gi = ag[((s2 + 1) * 32 + (C.tid & 31)) * 2 + 1];
            const float nr = a16r * sr - a16i * si + gr, ni = a16r * si + a16i * sr + gi; sr = nr; si = ni;
        }
#pragma unroll
        for (int k = 0; k < 16; ++k) {
            const int kk = seg * 16 + k, ch = dir ? 256 * b + 255 - kk : 256 * b + kk;
            so[(size_t)ch * 256] = (bf16_t)f2bf(sr); so[(size_t)ch * 256 + 64] = (bf16_t)f2bf(si);
            const float nr = ar * sr - ai * si + lr[k], ni = ar * si + ai * sr + li[k]; sr = nr; si = ni;
        }
        __syncthreads();
    }
}

__device__ __forceinline__ void phase_final(Ctx& C) {
    const int gw = C.bid * 8 + C.wave, NGW = C.G * 8;
    const float* fg = C.in[25];
    for (int row = gw; row < NLAT; row += NGW) {
        float* xr = C.out + (size_t)row * D; f32x4 x[4]; float q = 0.f;
#pragma unroll
        for (int j = 0; j < 4; ++j) { x[j] = *(const f32x4*)(xr + j * 256 + C.lane * 4); q += (x[j][0] * x[j][0] + x[j][1] * x[j][1]) + (x[j][2] * x[j][2] + x[j][3] * x[j][3]); }
        q = wave_sum(q); const float rs = rsqrtf(q * (1.0f / 1024.0f) + RMS_EPS);
#pragma unroll
        for (int j = 0; j < 4; ++j) { const f32x4 g = *(const f32x4*)(fg + j * 256 + C.lane * 4); *(f32x4*)(xr + j * 256 + C.lane * 4) = x[j] * rs * g; }
    }
}

template <class Epi>
__device__ __forceinline__ void gemm_plain(Ctx& C, const bf16_t* A, const bf16_t* Bt, int M, int N, int K, const Epi& E) {
    pg8::Seg s; s.A = (const char*)A; s.B = (const char*)Bt; s.tA = 256 * K * 2; s.tB = 256 * K * 2; s.gA = 0; s.gB = 0; s.hA = 128 * K * 2; s.hB = 128 * K * 2; s.kA = 128; s.kB = 128;
    const pg8::Voff v = pg8::voff_plain(C.tid, K * 2, K * 2);
    pg8::Order S; S.init(M / 256, N / 256, 1, C.G, C.bid);
    pg8::gemm_phase<Epi, false>(C.lds, s, s, K / 64, K / 64, v, v, S, E, C.tid);
}

constexpr int PH_PER_LAYER = 11, N_PHASES = 1 + DEPTH * PH_PER_LAYER + 1;

__global__ void __launch_bounds__(512, 2) mega(Args args) {
    extern __shared__ __attribute__((aligned(16))) unsigned char lds_raw[];
    Ctx C;
    C.in = args.in; C.out = args.out; C.ws = args.ws; C.lds = (LAS unsigned char*)lds_raw;
    C.G = gridDim.x; C.bid = blockIdx.x;
    const int wave0_ = __builtin_amdgcn_readfirstlane(threadIdx.x >> 6);
    volatile LAS unsigned* bst_ = (volatile LAS unsigned*)(C.lds + LDS_BYTES - 16);
    if (threadIdx.x == 0) { bst_[0] = 0u; bst_[1] = 0u; }
    __syncthreads();
    XcdBarrier xbar; xbar.bar = (unsigned*)(args.ws + WS_BAR); xbar.x = 0; xbar.st = bst_;
    if (args.coop) xbar = xcd_barrier_post((unsigned*)(args.ws + WS_BAR), bst_, (int)threadIdx.x);

    for (int ph = args.ph_lo; ph < args.ph_hi; ++ph) {
      const int nrep_ = (PROBE_SP == -1 ? (ph == 0) : (PROBE_SP >= 0 && ph >= 1 && ph < N_PHASES - 1 && (ph - 1) % PH_PER_LAYER == PROBE_SP)) ? 1 + PROBE_REP : 1;
      for (int rep_ = 0; rep_ < nrep_; ++rep_) {
        if (rep_ > 0 && args.coop) xcd_barrier(xbar, wave0_ * 64 + (int)__builtin_amdgcn_mbcnt_hi(~0u, __builtin_amdgcn_mbcnt_lo(~0u, 0u)));
        { int t_ = wave0_ * 64 + (int)__builtin_amdgcn_mbcnt_hi(~0u, __builtin_amdgcn_mbcnt_lo(~0u, 0u)); asm volatile("" : "+v"(t_)); C.tid = t_; C.lane = t_ & 63; C.wave = wave0_; }
        if (ph == 0) phase_p0(C);
        else if (ph == N_PHASES - 1) phase_final(C);
        else {
            const int l = (ph - 1) / PH_PER_LAYER, sp = (ph - 1) % PH_PER_LAYER;
            unsigned char* wt = C.ws + WS_WT;
            const int MR = (l == DEPTH - 1) ? NLAT : TR;
            switch ((ONLY_SP >= 0) ? ONLY_SP : sp) {
            case 0: phase_prep(C, l, rep_); break;
            case 1: phase_prep_b(C, l); break;
            case 2: {
                EpiIn E{WSP(float, WS_ROWSS), WSP(float, WS_CIN), WSP(bf16_t, WS_GB), WSP(bf16_t, WS_V), WSP(bf16_t, WS_U), WSP(bf16_t, WS_SGA), WSP(bf16_t, WS_YB)};
                gemm_plain(C, WSP(bf16_t, WS_XS), (const bf16_t*)(wt + WT_IN), TR, DIN, D, E);
            } break;
            case 3: {
                pg8::Seg s; s.A = (const char*)WSP(bf16_t, WS_U); s.B = (const char*)WSP(bf16_t, WS_WG);
                s.tA = 256 * 1024 * 2; s.gA = UROWS * 16 * 2; s.hA = 128 * 1024 * 2; s.kA = 128;
                s.tB = 0; s.gB = 256 * 1024 * 2; s.hB = 128 * 1024 * 2; s.kB = 128;
                const pg8::Voff v = pg8::voff_plain(C.tid, 2048, 2048);
                pg8::Order S; S.init(3, 1, NG, C.G, C.bid);
                EpiSloc E{WSP(float, WS_SLOC)};
                pg8::gemm_phase<EpiSloc, false>(C.lds, s, s, 16, 16, v, v, S, E, C.tid);
                if (rep_ == 0) phase_conv(C, l);
            } break;
            case 4: phase_scan(C, l); break;
            case 5: {
                pg8::Seg s0, s1;
                s0.A = (const char*)WSP(bf16_t, WS_U); s0.tA = 256 * 1024 * 2; s0.gA = UROWS * 16 * 2; s0.hA = 128 * 1024 * 2; s0.kA = 128;
                s0.B = (const char*)WSP(bf16_t, WS_KC) + 2 * 63 * 256 - 1536; s0.tB = 8192; s0.gB = 127 * 256 * 2; s0.hB = 4096; s0.kB = -2048;
                s1.A = (const char*)WSP(bf16_t, WS_SIN); s1.tA = 256 * 256 * 2; s1.gA = NCHP * 256 * 2; s1.hA = 128 * 256 * 2; s1.kA = 128;
                s1.B = (const char*)WSP(bf16_t, WS_MG); s1.tB = 256 * 256 * 2; s1.gB = 1024 * 256 * 2; s1.hB = 128 * 256 * 2; s1.kB = 128;
                pg8::Voff v0 = pg8::voff_plain(C.tid, 2048, 32), v1 = pg8::voff_plain(C.tid, 512, 512);
                {
                    int R, Cc; pg8::stage_rc(C.tid * 16, R, Cc); int Rb = (R & ~31) + pg8::perm32(R & 31);
                    v0.b0 = (unsigned)(Rb * 32 - (Cc >> 4) * 512 + (Cc & 15) * 2 + 1536);
                    pg8::stage_rc(C.tid * 16 + 8192, R, Cc); Rb = (R & ~31) + pg8::perm32(R & 31);
                    v0.b1 = (unsigned)(Rb * 32 - (Cc >> 4) * 512 + (Cc & 15) * 2 + 1536);
                }
                pg8::Order S; S.init(l == DEPTH - 1 ? 2 : 3, 4, NG, C.G, C.bid);
                EpiSsm E{WSP(bf16_t, WS_U), C.in[19] + (size_t)l * DS, WSP(bf16_t, WS_S)};
                pg8::gemm_phase<EpiSsm, true>(C.lds, s0, s1, 16, 20, v0, v1, S, E, C.tid);
            } break;
            case 6: {
                EpiGlu E{C.in[21] + (size_t)l * 2048, WSP(bf16_t, WS_YB)};
                gemm_plain(C, WSP(bf16_t, WS_S), (const bf16_t*)(wt + WT_GLU), MR, 2048, DS, E);
            } break;
            case 7: {
                EpiMerge E{WSP(bf16_t, WS_SGA), WSP(bf16_t, WS_YB)};
                gemm_plain(C, WSP(bf16_t, WS_GB), (const bf16_t*)(wt + WT_OUTA), MR, D, DC, E);
            } break;
            case 8: {
                const float* gsv = WSP(float, WS_GSV) + (size_t)l * 4 * 3 * D;
                EpiRes E{C.out, WSP(float, WS_CTXX), gsv + 2 * 3 * D, gsv + 1 * 3 * D, WSP(bf16_t, WS_XS), WSP(float, WS_ROWSS), 1};
                gemm_plain(C, WSP(bf16_t, WS_YB), (const bf16_t*)(wt + WT_O), MR, D, D, E);
            } break;
            case 9: {
#if PROBE_EMPTY
                if (rep_ > 0) { EpiNone E0{WSP(float, WS_CIN)}; gemm_plain(C, WSP(bf16_t, WS_XS), (const bf16_t*)(wt + WT_FFIN), MR, 2 * DFF, D, E0); break; }
#endif
                EpiFf E{WSP(float, WS_ROWSS), WSP(float, WS_CFF), WSP(bf16_t, WS_HID)};
                gemm_plain(C, WSP(bf16_t, WS_XS), (const bf16_t*)(wt + WT_FFIN), MR, 2 * DFF, D, E);
            } break;
            case 10: {
                const int ln = l + 1 < DEPTH ? l + 1 : l;
                const float* gsv = WSP(float, WS_GSV);
                EpiRes E{C.out, WSP(float, WS_CTXX), gsv + ((size_t)l * 4 + 3) * 3 * D, gsv + ((size_t)ln * 4 + 0) * 3 * D, WSP(bf16_t, WS_XS), WSP(float, WS_ROWSS), l + 1 < DEPTH ? 1 : 0};
                gemm_plain(C, WSP(bf16_t, WS_HID), (const bf16_t*)(wt + WT_FFOUT), MR, D, DFF, E);
            } break;
            }
        }
      }
        if (ph + 1 < args.ph_hi && args.coop) {
            if (ph + 2 == args.ph_hi) cg::this_grid().sync();
            else xcd_barrier(xbar, wave0_ * 64 + (int)__builtin_amdgcn_mbcnt_hi(~0u, __builtin_amdgcn_mbcnt_lo(~0u, 0u)));
        }
    }
}

extern "C" void kernel_launch(void* const* d_in, const int* in_sizes, int n_in, void* d_out, int out_size, void* d_ws, size_t ws_size, hipStream_t stream) {
    static int grid = 0;
    if (grid == 0) {
        if (n_in != 26 || out_size != NLAT * D || ws_size < WS_END) { fprintf(stderr, "kernel_launch: unexpected shapes (n_in %d out %d ws %zu need %zu)\n", n_in, out_size, ws_size, (size_t)WS_END); grid = -1; return; }
        if (hipFuncSetAttribute((const void*)mega, hipFuncAttributeMaxDynamicSharedMemorySize, LDS_BYTES) != hipSuccess) { fprintf(stderr, "hipFuncSetAttribute failed\n"); grid = -1; return; }
        int dev = 0, cus = 0, per_cu = 0;
        hipGetDevice(&dev); hipDeviceGetAttribute(&cus, hipDeviceAttributeMultiprocessorCount, dev);
        hipOccupancyMaxActiveBlocksPerMultiprocessor(&per_cu, (const void*)mega, 512, LDS_BYTES);
        (void)hipGetLastError();
        if (per_cu < 1) fprintf(stderr, "occupancy query says %d blocks per CU\n", per_cu);
        grid = cus > 0 ? cus : 256;
    }
    if (grid < 0) return;
    Args a{};
    for (int i = 0; i < 26; ++i) a.in[i] = (const float*)d_in[i];
    a.out = (float*)d_out; a.ws = (unsigned char*)d_ws; a.pad = 0;
#if MK_COOP
    if (hipMemsetAsync((char*)d_ws + WS_BAR, 0, 16384, stream) != hipSuccess) { fprintf(stderr, "memset failed\n"); return; }
    a.ph_lo = 0; a.ph_hi = N_PHASES; a.coop = 1;
    void* kargs[] = {&a};
    hipError_t e = hipLaunchCooperativeKernel((const void*)mega, dim3(grid), dim3(512), kargs, LDS_BYTES, stream);
    if (e != hipSuccess) fprintf(stderr, "cooperative launch failed: %s (grid %d)\n", hipGetErrorString(e), grid);
#else
    for (int ph = 0; ph < N_PHASES; ++ph) {
        a.ph_lo = ph; a.ph_hi = ph + 1; a.coop = 0;
        hipLaunchKernelGGL(mega, dim3(grid), dim3(512), LDS_BYTES, stream, a);
    }
#endif
}
```

```cpp
#include <hip/hip_runtime.h>
#include <hip/hip_cooperative_groups.h>
#include <cstdio>
#include <cstdint>
namespace cg = cooperative_groups;

#ifndef PROBE_CLK
#define PROBE_CLK 0
#endif
#ifndef PROBE_EMPTY
#define PROBE_EMPTY 0
#endif
#ifndef EPI_FENCE
#define EPI_FENCE
#endif
#ifndef ONLY_SP
#define ONLY_SP -1
#endif
#ifndef PROBE_SP
#define PROBE_SP -2
#endif
#define PROBE_REP 4
#ifndef MK_COOP
#define MK_COOP 1
#endif

#define LAS __attribute__((address_space(3)))
typedef unsigned short bf16_t;
typedef short bf16x8 __attribute__((ext_vector_type(8)));
typedef float f32x4 __attribute__((ext_vector_type(4)));
typedef unsigned u32x4 __attribute__((ext_vector_type(4)));

constexpr int D = 1024, SEQ = 16384, NLAT = 32768, CTXL = 256, NCTX = 512, TR = NLAT + NCTX  ;
constexpr int DEPTH = 4, DC = 512, DS = 512, NG = 32, NP = 64, DFF = 2816, DIN = 4096;
constexpr int NCH = TR / 64  , NCHP = NCH  , UROWS = TR;
constexpr float RMS_EPS = 1e-6f;

constexpr size_t al(size_t x) { return (x + 4095) & ~(size_t)4095; }
constexpr size_t WS_BAR = 0;
constexpr size_t WS_ROWSS = 16384;
constexpr size_t WS_RSTD = al(WS_ROWSS + (size_t)TR * 16 * 4);
constexpr size_t WS_MOD = al(WS_RSTD + (size_t)TR * 4);
constexpr size_t WS_GSV = al(WS_MOD + (size_t)4 * 3 * 6144 * 4);
constexpr size_t WS_CIN = al(WS_GSV + (size_t)4 * 4 * 3 * 1024 * 4);
constexpr size_t WS_CFF = al(WS_CIN + (size_t)3 * 4096 * 4);
constexpr size_t WS_APOW = al(WS_CFF + (size_t)3 * 5632 * 4);
constexpr size_t WS_BBAR = al(WS_APOW + (size_t)4 * 2 * 32 * 65 * 64 * 2 * 4);
constexpr size_t WS_KC = al(WS_BBAR + (size_t)4 * 2 * 32 * 64 * 16 * 2 * 4);
constexpr size_t KC_BYTES = al((size_t)32 * 127 * 256 * 2 + 8192), WG_BYTES = al((size_t)32 * 256 * 1024 * 2), MG_BYTES = al((size_t)32 * 1024 * 256 * 2);
constexpr size_t WS_WG = WS_KC + 2 * KC_BYTES;
constexpr size_t WS_MG = WS_WG + 2 * WG_BYTES;
constexpr size_t WS_SLOC = WS_MG + 2 * MG_BYTES;
constexpr size_t SLOC_HALF = al((size_t)32 * NCHP * 256 * 4);
constexpr size_t WS_SIN = WS_SLOC + 2 * SLOC_HALF;
constexpr size_t WS_CTXX = al(WS_SIN + (size_t)32 * NCHP * 256 * 2);
constexpr size_t WS_WT = al(WS_CTXX + (size_t)NCTX * D * 4);
constexpr size_t WT_IN = 0, WT_OUTA = WT_IN + (size_t)DIN * D * 2, WT_GLU = WT_OUTA + (size_t)D * DC * 2, WT_O = WT_GLU + (size_t)2048 * DS * 2,
                 WT_FFIN = WT_O + (size_t)D * D * 2, WT_FFOUT = WT_FFIN + (size_t)2 * DFF * D * 2, WT_END = WT_FFOUT + (size_t)D * DFF * 2;
constexpr size_t WT_BYTES = al(WT_END);
constexpr size_t WS_XS = WS_WT + 2 * WT_BYTES;
constexpr size_t WS_YB = al(WS_XS + (size_t)TR * D * 2);
constexpr size_t WS_GB = al(WS_YB + (size_t)TR * D * 2);
constexpr size_t WS_V = al(WS_GB + (size_t)TR * DC * 2);
constexpr size_t WS_U = al(WS_V + (size_t)TR * DC * 2);
constexpr size_t WS_S = al(WS_U + (size_t)NG * UROWS * 16 * 2);
constexpr size_t WS_SGA = al(WS_S + (size_t)TR * DS * 2);
constexpr size_t WS_OVL_END = al(WS_SGA + (size_t)TR * D * 2);
constexpr size_t WS_HID = WS_GB;
static_assert(WS_HID + (size_t)TR * DFF * 2 <= WS_OVL_END, "hid overlay");
constexpr size_t WS_END = WS_OVL_END;
static_assert(WS_END <= (size_t)512 * 1024 * 1024, "workspace");

constexpr int LDS_BYTES = 147456;

__device__ __forceinline__ int lane_id_v() { int l; asm volatile("v_mbcnt_lo_u32_b32 %0, -1, 0\n\tv_mbcnt_hi_u32_b32 %0, -1, %0" : "=v"(l)); return l; }
__device__ __forceinline__ unsigned f2bf(float f) { unsigned u = __builtin_bit_cast(unsigned, f); return (u + 0x7fffu + ((u >> 16) & 1u)) >> 16; }
__device__ __forceinline__ unsigned pk2(float lo, float hi) { unsigned r; asm("v_cvt_pk_bf16_f32 %0, %1, %2" : "=v"(r) : "v"(lo), "v"(hi)); return r; }
__device__ __forceinline__ float bflo(unsigned w) { return __builtin_bit_cast(float, w << 16); }
__device__ __forceinline__ float bfhi(unsigned w) { return __builtin_bit_cast(float, w & 0xffff0000u); }
__device__ __forceinline__ float sigm(float x) { return __builtin_amdgcn_rcpf(1.0f + __expf(-x)); }
__device__ __forceinline__ float wave_sum(float v) {
#pragma unroll
    for (int o = 1; o < 64; o <<= 1) v += __shfl_xor(v, o);
    return v;
}
__device__ __forceinline__ void sincos_cw(float x, float& s, float& c) {
    const float q = rintf(x * 0.63661977236758134f);
    float r = fmaf(-q, 1.5703125f, x);
    r = fmaf(-q, 4.837512969970703125e-4f, r);
    r = fmaf(-q, 7.54978995489188e-8f, r);
    const float r2 = r * r;
    float sp = fmaf(r2, 2.7557319e-6f, -1.9841270e-4f); sp = fmaf(sp, r2, 8.3333333e-3f); sp = fmaf(sp, r2, -1.6666667e-1f); sp = fmaf(sp * r2, r, r);
    float cp = fmaf(r2, -2.7557319e-7f, 2.4801587e-5f); cp = fmaf(cp, r2, -1.3888889e-3f); cp = fmaf(cp, r2, 4.1666667e-2f); cp = fmaf(cp, r2, -0.5f); cp = fmaf(cp, r2, 1.0f);
    const int qi = (int)q & 3;
    const float ss = (qi & 1) ? cp : sp, cc = (qi & 1) ? sp : cp;
    s = (qi & 2) ? -ss : ss; c = ((qi + 1) & 2) ? -cc : cc;
}


#define XB_TMO      128
#define XB_XCNT(j)  (256  + 64 * (j))
#define XB_XSUB(j)  (1280 + 64 * (j))
#define XB_XGEN(j)  (2304 + 64 * (j))
#define XB_TOP      3328
#define XB_TOPGEN   3392
#define XCD_BAR_WORDS 3456
#define XB_SPIN_CAP (1u << 18)
__device__ __forceinline__ unsigned xb_ld(unsigned* p)              { return __hip_atomic_load(p, __ATOMIC_RELAXED, __HIP_MEMORY_SCOPE_AGENT); }
__device__ __forceinline__ unsigned xb_add(unsigned* p, unsigned v) { return __hip_atomic_fetch_add(p, v, __ATOMIC_RELAXED, __HIP_MEMORY_SCOPE_AGENT); }
__device__ __forceinline__ unsigned xb_xcc_id() { return (unsigned)__builtin_amdgcn_s_getreg((3 << 11) | 20) & 0xFu; }
#define XB_SPIN(cond, bar) do { unsigned _sp = 0; while (cond) { __builtin_amdgcn_s_sleep(1); \
    if ((++_sp & 255u) == 0u) { if (xb_ld(&(bar)[XB_TMO])) break; if (_sp > XB_SPIN_CAP) { atomicAdd(&(bar)[XB_TMO], 1u); break; } } } } while (0)
struct XcdBarrier { unsigned* bar; unsigned x; volatile LAS unsigned* st; };
__device__ __forceinline__ XcdBarrier xcd_barrier_post(unsigned* bar, volatile LAS unsigned* st, int tid) {
    XcdBarrier b; b.bar = bar; b.x = xb_xcc_id(); b.st = st;
    if (tid == 0) (void)xb_add(&bar[XB_XCNT(b.x)], 1u);
    return b;
}
__device__ __forceinline__ void xcd_barrier_complete(unsigned* bar, unsigned x, unsigned& nloc, unsigned& nx) {
    const unsigned G = gridDim.x * gridDim.y * gridDim.z;
    unsigned sum, cnt, mine, sp = 0u;
    for (;;) {
        sum = 0u; cnt = 0u; mine = 0u;
#pragma unroll
        for (unsigned j = 0; j < 16; ++j) { const unsigned c = xb_ld(&bar[XB_XCNT(j)]); sum += c; cnt += (c > 0u) ? 1u : 0u; mine = (j == x) ? c : mine; }
        if (sum == G) break;
        __builtin_amdgcn_s_sleep(1);
        if ((++sp & 255u) == 0u) { if (xb_ld(&bar[XB_TMO])) break; if (sp > XB_SPIN_CAP) { atomicAdd(&bar[XB_TMO], 1u); break; } }
    }
    nloc = mine > 0u ? mine : 1u; nx = cnt > 0u ? cnt : 1u;
}
__device__ __forceinline__ void xcd_barrier(const XcdBarrier& b, int tid) {
    asm volatile("s_waitcnt vmcnt(0)" ::: "memory");
    __syncthreads();
    if (tid == 0) {
        unsigned* bar = b.bar;
        __builtin_amdgcn_s_waitcnt(0);
        unsigned nloc = b.st[0], nx = b.st[1];
        if (nloc == 0u) { xcd_barrier_complete(bar, b.x, nloc, nx); b.st[0] = nloc; b.st[1] = nx; }
        const unsigned old = xb_add(&bar[XB_XSUB(b.x)], 1u);
        const unsigned gen = old / nloc;
        if (old + 1u == (gen + 1u) * nloc) {
            __builtin_amdgcn_fence(__ATOMIC_RELEASE, "agent");
            asm volatile("s_waitcnt vmcnt(0)" ::: "memory");
            const unsigned og = xb_add(&bar[XB_TOP], 1u);
            const unsigned tg = og / nx;
            if (og + 1u == (tg + 1u) * nx) xb_add(&bar[XB_TOPGEN], 1u);
            else XB_SPIN(xb_ld(&bar[XB_TOPGEN]) == tg, bar);
            __builtin_amdgcn_fence(__ATOMIC_ACQUIRE, "agent");
            xb_add(&bar[XB_XGEN(b.x)], 1u);
            asm volatile("s_waitcnt vmcnt(0)" ::: "memory");
        } else {
            XB_SPIN(xb_ld(&bar[XB_XGEN(b.x)]) == gen, bar);
            __builtin_amdgcn_fence(__ATOMIC_ACQUIRE, "agent");
            asm volatile("s_waitcnt vmcnt(0)" ::: "memory");
        }
    }
    __syncthreads();
}

namespace pg8 {
constexpr int BM = 256, BK = 64, HALF = 128, HTB = HALF * BK * 2, STAGE_BYTES = 8 * HTB, NXCD = 8, WGM = 8;
__host__ __device__ __forceinline__ int lds_byte(int r, int c) { const int st = (r >> 4) * 2 + (c >> 5), rr = r & 15, cc = c & 31, ob = rr * 64 + cc * 2; return st * 1024 + (ob ^ (((ob >> 9) & 1) << 5)); }
__host__ __device__ __forceinline__ void stage_rc(int b, int& R, int& C) { const int st = b / 1024, sb = b % 1024, swz = sb ^ (((sb >> 9) & 1) << 5); R = (st >> 1) * 16 + swz / 64; C = (st & 1) * 32 + (swz % 64) / 2; }
__host__ __device__ __forceinline__ int perm32(int rho) { const int n = rho >> 4, i = rho & 15; return 8 * (i >> 2) + 4 * n + (i & 3); }

struct Unit { int pm, pn, g, ko, nt; };
struct Seg { const char* A; const char* B; int tA, tB, gA, gB, hA, hB, kA, kB; };

struct Order {
    int nM, nN, nwg, G, c, mode, nt;
    __device__ void init(int nM_, int nN_, int nG_, int G_, int c_, int nt_, int mode_ = -1) {
        nM = nM_; nN = nN_; mode = mode_ >= 0 ? mode_ : (nG_ > 1 ? 1 : 0); nt = nt_; G = G_; c = c_;
        nwg = nM * nN * nG_ * (mode == 2 ? 2 : 1) + (mode == 3 ? 32 : 0); }
    __device__ bool next(int i, Unit& u) const {
        long L = (long)i * G + c; if (L >= nwg) return false;
        u.ko = 0; u.nt = nt;
        if (mode == 1) { const int per = nM * nN; u.g = (int)L / per; const int r = (int)L % per; u.pm = r % nM; u.pn = r / nM; return true; }
        if (mode == 2) { const int h = (int)L & 1, L2 = (int)L >> 1; u.g = L2 / nM; u.pm = L2 % nM; u.pn = 0; u.ko = h * (nt / 2); u.nt = nt / 2; return true; }
        int nw = nwg;
        if (mode == 3) {
            if (L < 32) { const int sp = (int)L & 3, t8 = (int)L >> 2; u.g = 0; u.pm = 128 + (t8 >> 2); u.pn = t8 & 3; u.ko = sp == 0 ? 0 : (sp == 1 ? 12 : (sp == 2 ? 24 : 34)); u.nt = sp < 2 ? 12 : 10; return true; }
            L -= 32; nw -= 32; }
        int wgid = (int)L; { const int q = nw / NXCD, r = nw % NXCD, xcd = wgid % NXCD, off = wgid / NXCD; wgid = (xcd < r ? xcd * (q + 1) : r * (q + 1) + (xcd - r) * q) + off; }
        const int nig = WGM * nN, gid = wgid / nig, fm = gid * WGM, gsz = (nM - fm) < WGM ? (nM - fm) : WGM;
        u.pm = fm + ((wgid % nig) % gsz); u.pn = (wgid % nig) / gsz; u.g = 0; return true;
    }
};

struct Voff { unsigned a0, a1, b0, b1; };
__device__ __forceinline__ Voff voff_plain(int tid, int ldaB, int ldbB) {
    Voff v; int R, C;
    stage_rc(tid * 16, R, C); { const int Rb = (R & ~31) + perm32(R & 31); v.a0 = (unsigned)(R * ldaB + C * 2); v.b0 = (unsigned)(Rb * ldbB + C * 2); }
    stage_rc(tid * 16 + 8192, R, C); { const int Rb = (R & ~31) + perm32(R & 31); v.a1 = (unsigned)(R * ldaB + C * 2); v.b1 = (unsigned)(Rb * ldbB + C * 2); }
    return v;
}

#define EPI_ARGS const f32x4 (&acc)[2][2][4][2], const pg8::Unit& u, int wr, int wc, int fr, int fq

template <class Epi, bool TWOSEG>
__device__ __forceinline__ void gemm_phase(LAS unsigned char* lds, const Seg s0, const Seg s1, const int nt0, const Voff v0_in, const Voff v1_in, const Order& S, const Epi& E, const int tid) {
    const int wid = __builtin_amdgcn_readfirstlane(tid >> 6), lane = tid & 63, wr = wid >> 2, wc = wid & 3, fr = lane & 15, fq = lane >> 4;
    const unsigned ldsw = (unsigned)wid * 1024u;
    const int aoff = lds_byte(wr * 64 + fr, fq * 8), boff = lds_byte(wc * 32 + fr, fq * 8);
#define PG8_SA(b, h) (((b) * 2 + (h)) * HTB)
#define PG8_SB(b, h) ((4 + (b) * 2 + (h)) * HTB)
#define PG8_SEG1(t) (TWOSEG && (t) >= nt0)
#define PG8_UA(u, t) (PG8_SEG1(t) ? (s1.A + (long long)((u).g * s1.gA + (u).pm * s1.tA + ((t) - nt0) * s1.kA)) : (s0.A + (long long)((u).g * s0.gA + (u).pm * s0.tA + ((t) + (u).ko) * s0.kA)))
#define PG8_UB(u, t) (PG8_SEG1(t) ? (s1.B + (long long)((u).g * s1.gB + (u).pn * s1.tB + ((t) - nt0) * s1.kB)) : (s0.B + (long long)((u).g * s0.gB + (u).pn * s0.tB + ((t) + (u).ko) * s0.kB)))
#define PG8_HA(t) (PG8_SEG1(t) ? s1.hA : s0.hA)
#define PG8_HB(t) (PG8_SEG1(t) ? s1.hB : s0.hB)
#define PG8_STG(bufoff, gptr, o0, o1) do { \
        __builtin_amdgcn_global_load_lds((const unsigned*)((gptr) + (o0)), (LAS unsigned*)(lds + (bufoff) + ldsw), 16, 0, 0); \
        __builtin_amdgcn_global_load_lds((const unsigned*)((gptr) + (o1)), (LAS unsigned*)(lds + (bufoff) + ldsw + 8192), 16, 0, 0); } while (0)
#define PG8_STG_A(bufoff, gptr, t) do { const bool s_ = PG8_SEG1(t); PG8_STG(bufoff, gptr, s_ ? v1.a0 : v0.a0, s_ ? v1.a1 : v0.a1); } while (0)
#define PG8_STG_B(bufoff, gptr, t) do { const bool s_ = PG8_SEG1(t); PG8_STG(bufoff, gptr, s_ ? v1.b0 : v0.b0, s_ ? v1.b1 : v0.b1); } while (0)
#define PG8_LDA(dst, b, h) do { _Pragma("unroll") for (int m = 0; m < 4; ++m) _Pragma("unroll") for (int k = 0; k < 2; ++k) dst[m][k] = *(const LAS bf16x8*)(lds + PG8_SA(b, h) + aoff + m * 2048 + k * 1024); } while (0)
#define PG8_LDB(dst, b, h) do { _Pragma("unroll") for (int n = 0; n < 2; ++n) _Pragma("unroll") for (int k = 0; k < 2; ++k) dst[n][k] = *(const LAS bf16x8*)(lds + PG8_SB(b, h) + boff + n * 2048 + k * 1024); } while (0)
#define PG8_MMA(ai, bj, At, Bt) do { __builtin_amdgcn_s_setprio(1); _Pragma("unroll") for (int m = 0; m < 4; ++m) _Pragma("unroll") for (int n = 0; n < 2; ++n) _Pragma("unroll") for (int k = 0; k < 2; ++k) \
        acc[ai][bj][m][n] = __builtin_amdgcn_mfma_f32_16x16x32_bf16(Bt[n][k], At[m][k], acc[ai][bj][m][n], 0, 0, 0); __builtin_amdgcn_s_setprio(0); } while (0)
#define PG8_WAIT_V(n) asm volatile("s_waitcnt vmcnt(" #n ")" ::: "memory")
#define PG8_WAIT_L(n) asm volatile("s_waitcnt lgkmcnt(" #n ")" ::: "memory")
#define PG8_BAR __builtin_amdgcn_s_barrier()
#define PG8_SCHED __builtin_amdgcn_sched_barrier(0)
    Unit cur, nxt; int ui = 0;
    if (!S.next(0, cur)) return;
    f32x4 acc[2][2][4][2];
#pragma unroll
    for (int a = 0; a < 2; ++a)
#pragma unroll
        for (int b = 0; b < 2; ++b)
#pragma unroll
            for (int m = 0; m < 4; ++m)
#pragma unroll
                for (int n = 0; n < 2; ++n) acc[a][b][m][n] = (f32x4){0.f, 0.f, 0.f, 0.f};
    bf16x8 At[4][2], B0[2][2], B1[2][2];
    Voff v0 = v0_in, v1 = v1_in;
    asm volatile("" : "+v"(v0.a0), "+v"(v0.a1), "+v"(v0.b0), "+v"(v0.b1));
    if (TWOSEG) asm volatile("" : "+v"(v1.a0), "+v"(v1.a1), "+v"(v1.b0), "+v"(v1.b1));
    {
        const char* cA0 = PG8_UA(cur, 0); const char* cB0 = PG8_UB(cur, 0); const char* cA1 = PG8_UA(cur, 1); const char* cB1 = PG8_UB(cur, 1);
        PG8_STG_B(PG8_SB(0, 0), cB0, 0); PG8_STG_A(PG8_SA(0, 0), cA0, 0); PG8_STG_B(PG8_SB(0, 1), cB0 + PG8_HB(0), 0); PG8_STG_A(PG8_SA(0, 1), cA0 + PG8_HA(0), 0);
        if (wr == 1) PG8_BAR;
        PG8_WAIT_V(4); PG8_BAR;
        PG8_STG_B(PG8_SB(1, 0), cB1, 1); PG8_STG_A(PG8_SA(1, 0), cA1, 1); PG8_STG_B(PG8_SB(1, 1), cB1 + PG8_HB(1), 1);
        PG8_WAIT_V(6); PG8_BAR;
    }
    for (;;) {
        const bool has_next = S.next(ui + 1, nxt);
        Unit nu; nu.pm = has_next ? nxt.pm : cur.pm; nu.pn = has_next ? nxt.pn : cur.pn; nu.g = has_next ? nxt.g : cur.g; nu.ko = has_next ? nxt.ko : cur.ko; nu.nt = 0;
        int nt = cur.nt; asm volatile("" : "+s"(nt));
#pragma clang loop unroll(disable)
        for (int t = 0; t < nt; t += 2) {
            const bool last = (t == nt - 2);
            const int t1 = t + 1, t2 = last ? 0 : t + 2, t3 = t2 + 1;
            Unit u2; u2.pm = last ? nu.pm : cur.pm; u2.pn = last ? nu.pn : cur.pn; u2.g = last ? nu.g : cur.g; u2.ko = last ? nu.ko : cur.ko; u2.nt = 0;
            const char* a1 = PG8_UA(cur, t1);
            const char* a2 = PG8_UA(u2, t2); const char* b2 = PG8_UB(u2, t2);
            const char* a3 = PG8_UA(u2, t3); const char* b3 = PG8_UB(u2, t3);
            PG8_LDB(B0, 0, 0); PG8_SCHED; PG8_LDA(At, 0, 0); PG8_STG_A(PG8_SA(1, 1), a1 + PG8_HA(t1), t1);
            PG8_WAIT_L(8); PG8_BAR; PG8_WAIT_L(0); PG8_MMA(0, 0, At, B0); PG8_BAR; PG8_SCHED;
            PG8_LDB(B1, 0, 1); PG8_STG_B(PG8_SB(0, 0), b2, t2);
            PG8_BAR; PG8_WAIT_L(0); PG8_MMA(0, 1, At, B1); PG8_BAR;
            PG8_LDA(At, 0, 1); PG8_STG_A(PG8_SA(0, 0), a2, t2);
            PG8_BAR; PG8_WAIT_L(0); PG8_MMA(1, 0, At, B0); PG8_BAR; PG8_SCHED;
            PG8_STG_B(PG8_SB(0, 1), b2 + PG8_HB(t2), t2);
            PG8_WAIT_V(6); PG8_BAR; PG8_MMA(1, 1, At, B1); PG8_BAR;
            PG8_LDB(B0, 1, 0); PG8_SCHED; PG8_LDA(At, 1, 0); PG8_STG_A(PG8_SA(0, 1), a2 + PG8_HA(t2), t2);
            PG8_WAIT_L(8); PG8_BAR; PG8_WAIT_L(0); PG8_MMA(0, 0, At, B0); PG8_BAR; PG8_SCHED;
            PG8_LDB(B1, 1, 1); PG8_STG_B(PG8_SB(1, 0), b3, t3);
            PG8_BAR; PG8_WAIT_L(0); PG8_MMA(0, 1, At, B1); PG8_BAR;
            PG8_LDA(At, 1, 1); PG8_STG_A(PG8_SA(1, 0), a3, t3);
            PG8_BAR; PG8_WAIT_L(0); PG8_MMA(1, 0, At, B0); PG8_BAR; PG8_SCHED;
            PG8_STG_B(PG8_SB(1, 1), b3 + PG8_HB(t3), t3);
            PG8_WAIT_V(6); PG8_BAR; PG8_MMA(1, 1, At, B1); PG8_BAR;
        }
        E(acc, cur, wr, wc, fr, fq);
        if (!has_next) break;
#pragma unroll
        for (int a = 0; a < 2; ++a)
#pragma unroll
            for (int b = 0; b < 2; ++b)
#pragma unroll
                for (int m = 0; m < 4; ++m)
#pragma unroll
                    for (int n = 0; n < 2; ++n) acc[a][b][m][n] = (f32x4){0.f, 0.f, 0.f, 0.f};
        cur = nxt; ++ui;
    }
    PG8_WAIT_V(0);
    if (wr == 0) PG8_BAR;
    PG8_BAR;
#undef PG8_SA
#undef PG8_SB
#undef PG8_SEG1
#undef PG8_UA
#undef PG8_UB
#undef PG8_HA
#undef PG8_HB
#undef PG8_STG
#undef PG8_STG_A
#undef PG8_STG_B
#undef PG8_LDA
#undef PG8_LDB
#undef PG8_MMA
#undef PG8_WAIT_V
#undef PG8_WAIT_L
#undef PG8_BAR
#undef PG8_SCHED
}
}

struct Args { const float* in[26]; float* out; unsigned char* ws; int ph_lo, ph_hi, coop, pad; };

struct Ctx {
    const float* const* in; float* out; unsigned char* ws; LAS unsigned char* lds;
    int tid, lane, wave, G, bid;
};
#define WSP(T, off) ((T*)(C.ws + (off)))
__device__ __forceinline__ int sid_of_pm(int pm) { return pm < 64 ? 0 : (pm < 128 ? 1 : 2); }
__device__ __forceinline__ int sid_of_row(int r) { return r < SEQ ? 0 : (r < NLAT ? 1 : 2); }

struct F8 { f32x4 lo, hi; };
__device__ __forceinline__ F8 ld8(const float* p) { F8 r; r.lo = *(const f32x4*)p; r.hi = *(const f32x4*)(p + 4); return r; }
__device__ __forceinline__ void st8bf(bf16_t* p, const float (&v)[8]) { u32x4 w; w.x = pk2(v[0], v[1]); w.y = pk2(v[2], v[3]); w.z = pk2(v[4], v[5]); w.w = pk2(v[6], v[7]); *(u32x4*)p = w; }
__device__ __forceinline__ void ld8bf(const bf16_t* p, float (&v)[8]) { const u32x4 w = *(const u32x4*)p; v[0] = bflo(w.x); v[1] = bfhi(w.x); v[2] = bflo(w.y); v[3] = bfhi(w.y); v[4] = bflo(w.z); v[5] = bfhi(w.z); v[6] = bflo(w.w); v[7] = bfhi(w.w); }
#define ACC8(dst, ai, bj, m) do { _Pragma("unroll") for (int j_ = 0; j_ < 4; ++j_) { dst[j_] = acc[ai][bj][m][0][j_]; dst[4 + j_] = acc[ai][bj][m][1][j_]; } } while (0)
#define F8ARR(dst, f) do { _Pragma("unroll") for (int j_ = 0; j_ < 4; ++j_) { dst[j_] = (f).lo[j_]; dst[4 + j_] = (f).hi[j_]; } } while (0)
__device__ __forceinline__ float rstd_of(const float* rowss, int row) {
    const f32x4* p = (const f32x4*)(rowss + (size_t)row * 16); const f32x4 a = p[0], b = p[1], c = p[2], d = p[3];
    const float s = ((a[0] + a[1]) + (a[2] + a[3])) + ((b[0] + b[1]) + (b[2] + b[3])) + ((c[0] + c[1]) + (c[2] + c[3])) + ((d[0] + d[1]) + (d[2] + d[3]));
    return rsqrtf(s * (1.0f / 1024.0f) + RMS_EPS);
}

struct EpiIn {
    const float* rowss; const float* cin; bf16_t *gb, *v, *uu, *sga, *sgb;
    __device__ __forceinline__ void operator()(EPI_ARGS) const {
        const int sid = sid_of_pm(u.pm), lc = wc * 32 + 8 * fq, pn = u.pn;
        float c0[8], c1[8];
        { const F8 a = ld8(cin + sid * DIN + pn * 256 + lc), b = ld8(cin + sid * DIN + pn * 256 + 128 + lc); F8ARR(c0, a); F8ARR(c1, b); }
#pragma unroll
        for (int ai = 0; ai < 2; ++ai)
#pragma unroll
            for (int m = 0; m < 4; ++m) {
                const int row = u.pm * 256 + ai * 128 + wr * 64 + m * 16 + fr;
                const float rs = rowss[row];
                float z0[8], z1[8]; ACC8(z0, ai, 0, m); ACC8(z1, ai, 1, m);
#pragma unroll
                for (int j = 0; j < 8; ++j) { z0[j] = fmaf(rs, z0[j], c0[j]); z1[j] = fmaf(rs, z1[j], c1[j]); }
                if (pn < 2) { st8bf(gb + (size_t)row * DC + pn * 256 + lc, z0); st8bf(gb + (size_t)row * DC + pn * 256 + 128 + lc, z1); }
                else if (pn < 6) {
#pragma unroll
                    for (int j = 0; j < 8; ++j) z0[j] *= z1[j];
                    st8bf(v + (size_t)row * DC + (pn - 2) * 128 + lc, z0); }
                else if (pn < 8) {
                    const int col0 = (pn - 6) * 256 + lc, col1 = col0 + 128;
                    st8bf(uu + ((size_t)(col0 >> 4) * UROWS + row) * 16 + (col0 & 8), z0);
                    st8bf(uu + ((size_t)(col1 >> 4) * UROWS + row) * 16 + (col1 & 8), z1); }
                else {
#pragma unroll
                    for (int j = 0; j < 8; ++j) { z0[j] = sigm(z0[j]); z1[j] = sigm(z1[j]); }
                    bf16_t* dst = (pn < 12) ? (sga + (size_t)row * D + (pn - 8) * 256 + lc) : (sgb + (size_t)row * D + (pn - 12) * 256 + lc);
                    st8bf(dst, z0); st8bf(dst + 128, z1); }
                EPI_FENCE;
            }
    }
};
struct EpiSloc {
    float* sloc;
    __device__ __forceinline__ void operator()(EPI_ARGS) const {
        const int lc = wc * 32 + 8 * fq;
#pragma unroll
        for (int ai = 0; ai < 2; ++ai)
#pragma unroll
            for (int m = 0; m < 4; ++m) {
                const int ch = u.pm * 256 + ai * 128 + wr * 64 + m * 16 + fr;
                if (ch < NCH) {
                    float* dst = sloc + (u.ko ? SLOC_HALF / 4 : 0) + ((size_t)u.g * NCHP + ch) * 256 + lc;
                    *(f32x4*)(dst) = acc[ai][0][m][0]; *(f32x4*)(dst + 4) = acc[ai][0][m][1];
                    *(f32x4*)(dst + 128) = acc[ai][1][m][0]; *(f32x4*)(dst + 132) = acc[ai][1][m][1]; }
                EPI_FENCE;
            }
    }
};
struct EpiSsm {
    const bf16_t* uu; const float* dskip; bf16_t* s;
    __device__ __forceinline__ void operator()(EPI_ARGS) const {
        const int lc = wc * 32 + 8 * fq;
#pragma unroll
        for (int bj = 0; bj < 2; ++bj) {
            const int n = u.pn * 256 + bj * 128 + lc, t = n >> 4, hh = n & 8;
            float dk[8]; { const F8 a = ld8(dskip + u.g * 16 + hh); F8ARR(dk, a); }
#pragma unroll
            for (int ai = 0; ai < 2; ++ai)
#pragma unroll
                for (int m = 0; m < 4; ++m) {
                    const int ch = u.pm * 256 + ai * 128 + wr * 64 + m * 16 + fr;
                    if (ch < NCH) {
                        const int tok = ch * 64 + t;
                        float y[8], uv[8]; ACC8(y, ai, bj, m); ld8bf(uu + ((size_t)u.g * UROWS + tok) * 16 + hh, uv);
#pragma unroll
                        for (int j = 0; j < 8; ++j) { const float x = fmaf(dk[j], uv[j], y[j]); y[j] = x * sigm(1.5957691216f * (x + 0.044715f * x * x * x)); }
                        st8bf(s + (size_t)tok * DS + u.g * 16 + hh, y); }
                    EPI_FENCE;
                }
        }
    }
};
struct EpiGlu {
    const float* bglu; bf16_t* yb;
    __device__ __forceinline__ void operator()(EPI_ARGS) const {
        const int lc = wc * 32 + 8 * fq, col = u.pn * 128 + lc;
        float bv[8], bg[8]; { const F8 a = ld8(bglu + col), b = ld8(bglu + 1024 + col); F8ARR(bv, a); F8ARR(bg, b); }
#pragma unroll
        for (int ai = 0; ai < 2; ++ai)
#pragma unroll
            for (int m = 0; m < 4; ++m) {
                const int row = u.pm * 256 + ai * 128 + wr * 64 + m * 16 + fr;
                float vv[8], gg[8], sg[8]; ACC8(vv, ai, 0, m); ACC8(gg, ai, 1, m);
                bf16_t* p = yb + (size_t)row * D + col; ld8bf(p, sg);
#pragma unroll
                for (int j = 0; j < 8; ++j) vv[j] = sg[j] * (vv[j] + bv[j]) * sigm(gg[j] + bg[j]);
                st8bf(p, vv);
                EPI_FENCE;
            }
    }
};
struct EpiMerge {
    const bf16_t* sga; bf16_t* yb;
    __device__ __forceinline__ void operator()(EPI_ARGS) const {
        const int lc = wc * 32 + 8 * fq;
#pragma unroll
        for (int ai = 0; ai < 2; ++ai)
#pragma unroll
            for (int m = 0; m < 4; ++m) {
                const int row = u.pm * 256 + ai * 128 + wr * 64 + m * 16 + fr;
#pragma unroll
                for (int bj = 0; bj < 2; ++bj) {
                    const size_t o = (size_t)row * D + u.pn * 256 + bj * 128 + lc;
                    float ya[8], a[8], b[8]; ACC8(ya, ai, bj, m); ld8bf(sga + o, a); ld8bf(yb + o, b);
#pragma unroll
                    for (int j = 0; j < 8; ++j) ya[j] = fmaf(a[j], ya[j], b[j]);
                    st8bf(yb + o, ya); }
                EPI_FENCE;
            }
    }
};
template <int emit, int ctx_atomic>
struct EpiRes {
    float* xlat; float* xctx; const float* gate; const float* gsn; bf16_t* xs; float* rowss;
    __device__ __forceinline__ void operator()(EPI_ARGS) const {
        const int sid = sid_of_pm(u.pm), lc = wc * 32 + 8 * fq;
        if (ctx_atomic && u.pm >= 128) {
#pragma unroll
            for (int bj = 0; bj < 2; ++bj) {
                const int col = u.pn * 256 + bj * 128 + lc;
                float gt[8]; { const F8 a = ld8(gate + sid * D + col); F8ARR(gt, a); }
#pragma unroll
                for (int ai = 0; ai < 2; ++ai)
#pragma unroll
                    for (int m = 0; m < 4; ++m) {
                        const int row = u.pm * 256 + ai * 128 + wr * 64 + m * 16 + fr;
                        float* xp = xctx + (size_t)(row - NLAT) * D + col;
                        float y[8]; ACC8(y, ai, bj, m);
#pragma unroll
                        for (int j = 0; j < 8; ++j) unsafeAtomicAdd(xp + j, gt[j] * y[j]);
                    }
            }
            return;
        }
        float ss[2][4];
#pragma unroll
        for (int ai = 0; ai < 2; ++ai)
#pragma unroll
            for (int m = 0; m < 4; ++m) ss[ai][m] = 0.f;
#pragma unroll
        for (int bj = 0; bj < 2; ++bj) {
            const int col = u.pn * 256 + bj * 128 + lc;
            float gt[8], gs[8]; { const F8 a = ld8(gate + sid * D + col); F8ARR(gt, a); }
            if (emit) { const F8 b = ld8(gsn + sid * D + col); F8ARR(gs, b); } else {
#pragma unroll
                for (int j = 0; j < 8; ++j) gs[j] = 0.f; }
#pragma unroll
            for (int ai = 0; ai < 2; ++ai)
#pragma unroll
                for (int m = 0; m < 4; ++m) {
                    const int row = u.pm * 256 + ai * 128 + wr * 64 + m * 16 + fr;
                    float* xp = (row < NLAT ? xlat + (size_t)row * D : xctx + (size_t)(row - NLAT) * D) + col;
                    float y[8], x[8]; ACC8(y, ai, bj, m); { const F8 a = ld8(xp); F8ARR(x, a); }
                    float q = 0.f;
#pragma unroll
                    for (int j = 0; j < 8; ++j) { x[j] = fmaf(gt[j], y[j], x[j]); q = fmaf(x[j], x[j], q); }
                    *(f32x4*)xp = (f32x4){x[0], x[1], x[2], x[3]}; *(f32x4*)(xp + 4) = (f32x4){x[4], x[5], x[6], x[7]};
                    if (emit) {
#pragma unroll
                        for (int j = 0; j < 8; ++j) x[j] *= gs[j];
                        st8bf(xs + (size_t)row * D + col, x); }
                    ss[ai][m] += q;
                    asm volatile("" : "+v"(ss[ai][m]) :: "memory");
                }
        }
        if (emit) {
#pragma unroll
            for (int ai = 0; ai < 2; ++ai)
#pragma unroll
                for (int m = 0; m < 4; ++m) {
                    float q = ss[ai][m]; q += __shfl_xor(q, 16); q += __shfl_xor(q, 32);
                    const int row = u.pm * 256 + ai * 128 + wr * 64 + m * 16 + fr;
                    if (fq == 0) rowss[(size_t)row * 16 + u.pn * 4 + wc] = q; }
        }
    }
};
struct EpiNone { float* sink; __device__ __forceinline__ void operator()(EPI_ARGS) const {
    float t = 0.f;
#pragma unroll
    for (int ai = 0; ai < 2; ++ai)
#pragma unroll
        for (int bj = 0; bj < 2; ++bj)
#pragma unroll
            for (int m = 0; m < 4; ++m)
#pragma unroll
                for (int n = 0; n < 2; ++n) t += (acc[ai][bj][m][n][0] + acc[ai][bj][m][n][1]) + (acc[ai][bj][m][n][2] + acc[ai][bj][m][n][3]);
    if (t == 1.2345678e33f) sink[u.pm + wr + wc + fr + fq] = t; } };
template <int PV>
struct EpiFfT {
    const float* rowss; const float* cff; bf16_t* hid;
    __device__ __forceinline__ void operator()(EPI_ARGS) const {
        const int sid = sid_of_pm(u.pm), lc = wc * 32 + 8 * fq;
        float c0[8], c1[8];
        if (PV == 4) {
#pragma unroll
            for (int j = 0; j < 8; ++j) { c0[j] = 0.01f * j; c1[j] = 0.02f * j; } } else { const F8 a = ld8(cff + sid * 2 * DFF + u.pn * 256 + lc), b = ld8(cff + sid * 2 * DFF + u.pn * 256 + 128 + lc); F8ARR(c0, a); F8ARR(c1, b); }
#pragma unroll
        for (int ai = 0; ai < 2; ++ai)
#pragma unroll
            for (int m = 0; m < 4; ++m) {
                const int row = u.pm * 256 + ai * 128 + wr * 64 + m * 16 + fr;
                const float rs = rowss[row];
                float g[8], uu[8]; ACC8(g, ai, 0, m); ACC8(uu, ai, 1, m);
#pragma unroll
                for (int j = 0; j < 8; ++j) { const float gg = fmaf(rs, g[j], c0[j]), uv = fmaf(rs, uu[j], c1[j]); g[j] = gg * sigm(gg) * uv; }
                if (PV != 3 || g[0] == 1.2345678e33f) st8bf(hid + (size_t)row * DFF + u.pn * 128 + lc, g);
                EPI_FENCE;
            }
    }
};

typedef EpiFfT<0> EpiFf;
template <int MAP  >
__device__ __forceinline__ int colmap(int v) {
    if (MAP == 1) { if (v >= 512 && v < 1536) { const int q = (v - 512) >> 8, r = (v - 512) & 255; return r < 128 ? 512 + 128 * q + r : 1024 + 128 * q + (r - 128); } return v; }
    if (MAP == 2) { const int q = v >> 8, r = v & 255; return r < 128 ? 128 * q + r : DFF + 128 * q + (r - 128); }
    return v;
}
template <int MAP>
__device__ __forceinline__ void gemv3_item(Ctx& C, int item, const float* W, int ldw, const LAS float* vecs, LAS float* red, const float* bias, float* out, int ostride) {
    const int vcol = item * 64 + C.lane, oc = colmap<MAP>(vcol);
    float a0 = 0.f, a1 = 0.f, a2 = 0.f;
    const int k0 = C.wave * 128;
#pragma unroll 1
    for (int kb = 0; kb < 4; ++kb) {
        float w[32];
#pragma unroll
        for (int i = 0; i < 32; ++i) w[i] = W[(size_t)(k0 + kb * 32 + i) * ldw + oc];
#pragma unroll
        for (int i = 0; i < 32; ++i) { const int k = k0 + kb * 32 + i; a0 = fmaf(vecs[k], w[i], a0); a1 = fmaf(vecs[1024 + k], w[i], a1); a2 = fmaf(vecs[2048 + k], w[i], a2); }
    }
    red[(C.wave * 3 + 0) * 64 + C.lane] = a0; red[(C.wave * 3 + 1) * 64 + C.lane] = a1; red[(C.wave * 3 + 2) * 64 + C.lane] = a2;
    __syncthreads();
    if (C.tid < 192) {
        const int s = C.tid >> 6, l = C.tid & 63; float r = 0.f;
#pragma unroll
        for (int w = 0; w < 8; ++w) r += red[(w * 3 + s) * 64 + l];
        const int vc = item * 64 + l, o2 = colmap<MAP>(vc);
        out[(size_t)s * ostride + vc] = r + (bias ? bias[o2] : 0.f);
    }
    __syncthreads();
}

template <int MAP  >
__device__ __forceinline__ int vrow_of(int n) {
    if (MAP == 1) { if (n >= 512 && n < 1024) { const int q = (n - 512) >> 7, r = (n - 512) & 127; return 512 + 256 * q + r; }
                    if (n >= 1024 && n < 1536) { const int q = (n - 1024) >> 7, r = (n - 1024) & 127; return 512 + 256 * q + 128 + r; } return n; }
    if (MAP == 2) { return n < 1024 ? 256 * (n >> 7) + (n & 127) : 256 * ((n - 1024) >> 7) + 128 + ((n - 1024) & 127); }
    if (MAP == 3) { return n < DFF ? 256 * (n >> 7) + (n & 127) : 256 * ((n - DFF) >> 7) + 128 + ((n - DFF) & 127); }
    return n;
}
template <int MAP>
__device__ __forceinline__ void transpose_item(const float* W, int K, int N, bf16_t* WT, LAS float* scr, int item, int lane) {
    const int nblk = N / 32, kb = item / nblk, nb = item % nblk, k0 = 64 * kb, n0 = 32 * nb;
#pragma unroll 8
    for (int i = 0; i < 32; ++i) { const int kk = 2 * i + (lane >> 5); scr[kk * 33 + (lane & 31)] = W[(size_t)(k0 + kk) * N + n0 + (lane & 31)]; }
    asm volatile("s_waitcnt lgkmcnt(0)" ::: "memory");
    const int c = lane & 7;
#pragma unroll
    for (int j = 0; j < 4; ++j) { const int n = (lane >> 3) + 8 * j; const LAS float* s = scr + (8 * c) * 33 + n;
        u32x4 o; o.x = pk2(s[0 * 33], s[1 * 33]); o.y = pk2(s[2 * 33], s[3 * 33]); o.z = pk2(s[4 * 33], s[5 * 33]); o.w = pk2(s[6 * 33], s[7 * 33]);
        *(u32x4*)(WT + (size_t)vrow_of<MAP>(n0 + n) * K + k0 + 8 * c) = o; }
    asm volatile("s_waitcnt lgkmcnt(0)" ::: "memory");
}

__device__ __forceinline__ void phase_p0(Ctx& C) {
    float* mod = WSP(float, WS_MOD);
    {
        LAS float* vecs = (LAS float*)C.lds; LAS float* red = vecs + 3072;
        for (int i = C.tid; i < 3072; i += 512) { const float x = i < 2048 ? C.in[1][i] : C.in[3][i - 2048]; vecs[i] = x * sigm(x); }
        __syncthreads();
        for (int it = C.bid; it < DEPTH * 96; it += C.G) {
            const int l = it / 96, item = it % 96;
            gemv3_item<0>(C, item, C.in[4] + (size_t)l * D * 6144, 6144, vecs, red, C.in[5] + (size_t)l * 6144, mod + (size_t)l * 3 * 6144, 6144);
        }
    }
    float* apow = WSP(float, WS_APOW); float* bbar = WSP(float, WS_BBAR);
    const int gt = C.bid * 512 + C.tid, GT = C.G * 512;
    for (int i = gt; i < DEPTH * 2 * NG * 65 * NP; i += GT) {
        const int p = i & 63, e = (i >> 6) % 65, ldg = (i >> 6) / 65;
        const float dt = expf(C.in[14][ldg]);
        const float lr = C.in[12][ldg * 64 + p], li = C.in[13][ldg * 64 + p];
        const float mag = expf((float)e * lr * dt); float s, c; sincos_cw((float)e * (li * dt), s, c);
        apow[(size_t)i * 2] = mag * c; apow[(size_t)i * 2 + 1] = mag * s;
    }
    for (int i = gt; i < DEPTH * 2 * NG * NP; i += GT) {
        const int ldg = i >> 6;
        const float dt = expf(C.in[14][ldg]);
        const float lr = C.in[12][i], li = C.in[13][i];
        const float mag = expf(lr * dt); float s, c; sincos_cw(li * dt, s, c);
        const float ar = mag * c, ai = mag * s, nr = ar - 1.0f, ni = ai, den = lr * lr + li * li;
        const float fr = (nr * lr + ni * li) / den, fi = (ni * lr - nr * li) / den;
        const float* br = C.in[15] + (size_t)i * 16; const float* bi = C.in[16] + (size_t)i * 16;
#pragma unroll
        for (int h = 0; h < 16; ++h) { const float x = br[h], y = bi[h]; bbar[((size_t)i * 16 + h) * 2] = fr * x - fi * y; bbar[((size_t)i * 16 + h) * 2 + 1] = fr * y + fi * x; }
    }
}

#ifndef PREP_PART
#define PREP_PART 15
#endif
__device__ __forceinline__ void phase_prep(Ctx& C, int l, int vb, int VG, int parts) {
    if (parts & (16 | 32 | 64 | 128 | 256 | 512)) {
        LAS float* scr = (LAS float*)(C.lds + 8192 + C.wave * 8448);
        unsigned char* wt = C.ws + WS_WT + (size_t)(l & 1) * WT_BYTES;
        const int gw = vb * 8 + C.wave, NGW = VG * 8;
        if (parts & 16) for (int it = gw; it < 16 * 128; it += NGW) transpose_item<1>(C.in[8] + (size_t)l * D * DIN, D, DIN, (bf16_t*)(wt + WT_IN), scr, it, C.lane);
        if (parts & 32) for (int it = gw; it < 8 * 32; it += NGW) transpose_item<0>(C.in[11] + (size_t)l * DC * D, DC, D, (bf16_t*)(wt + WT_OUTA), scr, it, C.lane);
        if (parts & 64) for (int it = gw; it < 8 * 64; it += NGW) transpose_item<2>(C.in[20] + (size_t)l * DS * 2048, DS, 2048, (bf16_t*)(wt + WT_GLU), scr, it, C.lane);
        if (parts & 128) for (int it = gw; it < 16 * 32; it += NGW) transpose_item<0>(C.in[22] + (size_t)l * D * D, D, D, (bf16_t*)(wt + WT_O), scr, it, C.lane);
        if (parts & 256) for (int it = gw; it < 16 * 176; it += NGW) transpose_item<3>(C.in[23] + (size_t)l * D * 2 * DFF, D, 2 * DFF, (bf16_t*)(wt + WT_FFIN), scr, it, C.lane);
        if (parts & 512) for (int it = gw; it < 44 * 32; it += NGW) transpose_item<0>(C.in[24] + (size_t)l * DFF * D, DFF, D, (bf16_t*)(wt + WT_FFOUT), scr, it, C.lane);
        __syncthreads();
    }
    const int gt = vb * 512 + C.tid, GT = VG * 512;
    if (parts & 1024) {
        float* gsv = WSP(float, WS_GSV); const float* modall = WSP(float, WS_MOD);
        for (int i = gt; i < DEPTH * 4 * 3 * D; i += GT) {
            const int k = i & 1023, sid = (i >> 10) % 3, w = ((i >> 10) / 3) & 3, ll = (i >> 10) / 12;
            const float* mv = modall + ((size_t)ll * 3 + sid) * 6144;
            float r;
            if (w == 0) r = C.in[6][ll * D + k] * (1.0f + mv[1024 + k]);
            else if (w == 1) r = C.in[7][ll * D + k] * (1.0f + mv[4096 + k]);
            else if (w == 2) r = mv[2048 + k];
            else r = mv[5120 + k];
            gsv[i] = r;
        }
    }
    const float* apow = WSP(float, WS_APOW) + (size_t)l * 2 * NG * 65 * NP * 2;
    const float* bbar = WSP(float, WS_BBAR) + (size_t)l * 2 * NG * NP * 16 * 2;
    const float* cre = C.in[17] + (size_t)l * 2 * NG * 16 * NP; const float* cim = C.in[18] + (size_t)l * 2 * NG * 16 * NP;
    if (parts & 4) {
        bf16_t* kc = WSP(bf16_t, WS_KC + (size_t)(l & 1) * KC_BYTES);
        LAS float* Es = (LAS float*)C.lds;
        LAS float* Cs = Es + 2 * 4 * 16 * 132;
        for (int it = vb; it < NG * 16; it += VG) {
            const int g = it >> 4, eg = it & 15;
#pragma unroll 4
            for (int i = 0; i < 16; ++i) {
                const int idx = C.tid + 512 * i, p = idx & 63, hi = (idx >> 6) & 15, e4 = (idx >> 10) & 3, dir = idx >> 12, e = eg * 4 + e4;
                const float* ap = apow + (((size_t)(dir * NG + g) * 65 + e) * NP + p) * 2; const float* bb = bbar + ((size_t)(dir * NG + g) * NP + p) * 32 + hi * 2;
                const float pr = ap[0], pi = ap[1], br = bb[0], bi = bb[1];
                Es[((dir * 4 + e4) * 16 + hi) * 132 + p * 2] = pr * br - pi * bi; Es[((dir * 4 + e4) * 16 + hi) * 132 + p * 2 + 1] = pr * bi + pi * br;
            }
#pragma unroll
            for (int i = 0; i < 4; ++i) {
                const int idx = C.tid + 512 * i, p = idx & 63, ho = (idx >> 6) & 15, dir = idx >> 10;
                Cs[(dir * 16 + ho) * 132 + p * 2] = cre[((size_t)(dir * NG + g) * 16 + ho) * NP + p]; Cs[(dir * 16 + ho) * 132 + p * 2 + 1] = cim[((size_t)(dir * NG + g) * 16 + ho) * NP + p];
            }
            __syncthreads();
#pragma unroll 1
            for (int i = 0; i < 4; ++i) {
                const int o = C.tid + 512 * i, hi = o & 15, ho = (o >> 4) & 15, e4 = (o >> 8) & 3, dir = o >> 10, e = eg * 4 + e4;
                float val = 0.f;
                const int nd = (e == 0 && dir == 0) ? 2 : 1;
                for (int dd2 = 0; dd2 < nd; ++dd2) {
                    const int d2 = dir + dd2;
                    const LAS f32x4* er = (const LAS f32x4*)(Es + ((d2 * 4 + e4) * 16 + hi) * 132); const LAS f32x4* cr4 = (const LAS f32x4*)(Cs + (d2 * 16 + ho) * 132);
#pragma unroll 8
                    for (int q = 0; q < 32; ++q) { const f32x4 ev = er[q], cv = cr4[q]; val += (cv[0] * ev[0] - cv[1] * ev[1]) + (cv[2] * ev[2] - cv[3] * ev[3]); }
                }
                if (!(e == 0 && dir == 1)) { const int dd = dir ? 63 - e : 63 + e; kc[((size_t)g * 127 + dd) * 256 + ho * 16 + hi] = (bf16_t)f2bf(val); }
            }
            __syncthreads();
        }
    }
    if (parts & 8) {
        bf16_t* wg = WSP(bf16_t, WS_WG + (size_t)(l & 1) * WG_BYTES);
        for (int i = gt; i < NG * 256 * 64; i += GT) {
            const int j = i & 63, n = (i >> 6) & 255, g = i >> 14, dir = n >> 7, ri = (n >> 6) & 1, p = n & 63, e = dir ? j : 63 - j;
            const float* ap = apow + (((size_t)(dir * NG + g) * 65 + e) * NP + p) * 2; const float pr = ap[0], pi = ap[1];
            const float* bb = bbar + ((size_t)(dir * NG + g) * NP + p) * 32;
            float o[16];
#pragma unroll
            for (int h = 0; h < 16; ++h) { const float br = bb[h * 2], bi = bb[h * 2 + 1]; o[h] = ri ? (pr * bi + pi * br) : (pr * br - pi * bi); }
            u32x4 w0, w1; w0.x = pk2(o[0], o[1]); w0.y = pk2(o[2], o[3]); w0.z = pk2(o[4], o[5]); w0.w = pk2(o[6], o[7]);
            w1.x = pk2(o[8], o[9]); w1.y = pk2(o[10], o[11]); w1.z = pk2(o[12], o[13]); w1.w = pk2(o[14], o[15]);
            u32x4* dst = (u32x4*)(wg + ((size_t)g * 256 + n) * 1024 + j * 16); dst[0] = w0; dst[1] = w1;
        }
    }
    if (parts & 8) {
        bf16_t* mg = WSP(bf16_t, WS_MG + (size_t)(l & 1) * MG_BYTES);
        for (int i = gt; i < NG * 1024 * 32; i += GT) {
            const int kc8 = i & 31, n = (i >> 5) & 1023, g = i >> 15, t = n >> 4, ho = n & 15, k0 = kc8 * 8, dir = k0 >> 7, ri = (k0 >> 6) & 1, p0 = k0 & 63, e = dir ? 64 - t : t + 1;
            const f32x4* ap4 = (const f32x4*)(apow + (((size_t)(dir * NG + g) * 65 + e) * NP + p0) * 2);
            const f32x4* cr4 = (const f32x4*)(cre + ((size_t)(dir * NG + g) * 16 + ho) * NP + p0); const f32x4* ci4 = (const f32x4*)(cim + ((size_t)(dir * NG + g) * 16 + ho) * NP + p0);
            const f32x4 a0 = ap4[0], a1 = ap4[1], a2 = ap4[2], a3 = ap4[3], c0 = cr4[0], c1 = cr4[1], d0 = ci4[0], d1 = ci4[1];
            const float prs[8] = {a0[0], a0[2], a1[0], a1[2], a2[0], a2[2], a3[0], a3[2]}, pis[8] = {a0[1], a0[3], a1[1], a1[3], a2[1], a2[3], a3[1], a3[3]};
            const float crs[8] = {c0[0], c0[1], c0[2], c0[3], c1[0], c1[1], c1[2], c1[3]}, cis[8] = {d0[0], d0[1], d0[2], d0[3], d1[0], d1[1], d1[2], d1[3]};
            float o[8];
#pragma unroll
            for (int q = 0; q < 8; ++q) o[q] = ri ? -(crs[q] * pis[q] + cis[q] * prs[q]) : (crs[q] * prs[q] - cis[q] * pis[q]);
            st8bf(mg + ((size_t)g * 1024 + n) * 256 + k0, o);
        }
    }
    if (parts & 1024) {
        const float* modall = WSP(float, WS_MOD);
        const int gw = vb * 8 + C.wave, NGW = VG * 8;
        for (int row = gw; row < TR; row += NGW) {
            const int sid = sid_of_row(row);
            const float* src = row < NLAT ? C.in[0] + (size_t)row * D : C.in[2] + (size_t)(row - NLAT) * D;
            float* dst = row < NLAT ? C.out + (size_t)row * D : WSP(float, WS_CTXX) + (size_t)(row - NLAT) * D;
            bf16_t* xs = WSP(bf16_t, WS_XS) + (size_t)row * D;
            float q = 0.f;
#pragma unroll
            for (int j = 0; j < 4; ++j) {
                const int k = j * 256 + C.lane * 4;
                const f32x4 x = *(const f32x4*)(src + k), ng = *(const f32x4*)(C.in[6] + k), sc = *(const f32x4*)(modall + (size_t)sid * 6144 + 1024 + k);
                *(f32x4*)(dst + k) = x; q += (x[0] * x[0] + x[1] * x[1]) + (x[2] * x[2] + x[3] * x[3]);
                const unsigned w0 = pk2(x[0] * ng[0] * (1.f + sc[0]), x[1] * ng[1] * (1.f + sc[1])), w1 = pk2(x[2] * ng[2] * (1.f + sc[2]), x[3] * ng[3] * (1.f + sc[3]));
                *(unsigned long long*)(xs + k) = (unsigned long long)w0 | ((unsigned long long)w1 << 32);
            }
            q = wave_sum(q);
            if (C.lane < 16) WSP(float, WS_ROWSS)[(size_t)row * 16 + C.lane] = C.lane == 0 ? q : 0.f;
        }
    }
}

__device__ __forceinline__ void phase_rstd(Ctx& C, int nrows) {
    for (int row = C.bid * 512 + C.tid; row < nrows; row += C.G * 512) WSP(float, WS_RSTD)[row] = rstd_of(WSP(float, WS_ROWSS), row);
}

__device__ __forceinline__ void phase_prep_b(Ctx& C, int l) {
    const float* mod = WSP(float, WS_MOD) + (size_t)l * 3 * 6144;
    const int gw = C.bid * 8 + C.wave, NGW = C.G * 8;
    if (l > 0) {
        const float* gs = WSP(float, WS_GSV) + ((size_t)l * 4 + 0) * 3 * D + 2 * D;
        for (int r = gw; r < NCTX; r += NGW) {
            const float* src = WSP(float, WS_CTXX) + (size_t)r * D; bf16_t* xs = WSP(bf16_t, WS_XS) + (size_t)(NLAT + r) * D; float q = 0.f;
#pragma unroll
            for (int j = 0; j < 4; ++j) {
                const int k = j * 256 + C.lane * 4;
                const f32x4 x = *(const f32x4*)(src + k), g = *(const f32x4*)(gs + k);
                q += (x[0] * x[0] + x[1] * x[1]) + (x[2] * x[2] + x[3] * x[3]);
                const unsigned w0 = pk2(x[0] * g[0], x[1] * g[1]), w1 = pk2(x[2] * g[2], x[3] * g[3]);
                *(unsigned long long*)(xs + k) = (unsigned long long)w0 | ((unsigned long long)w1 << 32);
            }
            q = wave_sum(q);
            if (C.lane < 16) WSP(float, WS_ROWSS)[(size_t)(NLAT + r) * 16 + C.lane] = C.lane == 0 ? q : 0.f;
            if (C.lane == 0) WSP(float, WS_RSTD)[NLAT + r] = rsqrtf(q * (1.0f / 1024.0f) + RMS_EPS);
        }
    }
    phase_rstd(C, l > 0 ? NLAT : TR);
#pragma unroll 1
    for (int which = 0; which < 2; ++which) {
        const int NV = which ? 2 * DFF : DIN;
        const bf16_t* wt = (const bf16_t*)(C.ws + WS_WT + (size_t)(l & 1) * WT_BYTES + (which ? WT_FFIN : WT_IN));
        const float* shb = mod + (which ? 3072 : 0);
        float sh[3][16];
#pragma unroll
        for (int sdx = 0; sdx < 3; ++sdx)
#pragma unroll
            for (int j = 0; j < 2; ++j) { const F8 a = ld8(shb + (size_t)sdx * 6144 + j * 512 + C.lane * 8); F8ARR((&sh[sdx][j * 8]), a); }
        float* out = which ? WSP(float, WS_CFF) : WSP(float, WS_CIN);
        for (int v = gw; v < NV; v += NGW) {
            float w0[8], w1[8]; ld8bf(wt + (size_t)v * D + C.lane * 8, w0); ld8bf(wt + (size_t)v * D + 512 + C.lane * 8, w1);
            float r0 = 0.f, r1 = 0.f, r2 = 0.f;
#pragma unroll
            for (int j = 0; j < 8; ++j) { r0 += sh[0][j] * w0[j] + sh[0][8 + j] * w1[j]; r1 += sh[1][j] * w0[j] + sh[1][8 + j] * w1[j]; r2 += sh[2][j] * w0[j] + sh[2][8 + j] * w1[j]; }
            r0 = wave_sum(r0); r1 = wave_sum(r1); r2 = wave_sum(r2);
            if (C.lane == 0) {
                const float bb = which ? 0.f : C.in[9][(size_t)l * DIN + colmap<1>(v)];
                out[v] = r0 + bb; out[NV + v] = r1 + bb; out[2 * NV + v] = r2 + bb; }
        }
    }
}

__device__ __forceinline__ void phase_conv(Ctx& C, int l, int vb, int VG) {
    const float* cw = C.in[10] + (size_t)l * 3 * DC;
    bf16_t* gb = WSP(bf16_t, WS_GB); const bf16_t* v = WSP(bf16_t, WS_V);
    const int gt = vb * 512 + C.tid, GT = VG * 512;
    for (int i = gt; i < TR * 64; i += GT) {
        const int row = i >> 6, c8 = (i & 63) * 8;
        const bool lat = row < NLAT; const int pos = lat ? (row & 63) : ((row - NLAT) & 255), lastp = lat ? 63 : 255;
        float a[8], b[8], c[8], g[8], w0[8], w1[8], w2[8];
        ld8bf(v + (size_t)row * DC + c8, b);
        if (pos > 0) ld8bf(v + (size_t)(row - 1) * DC + c8, a); else {
#pragma unroll
            for (int j = 0; j < 8; ++j) a[j] = 0.f; }
        if (pos < lastp) ld8bf(v + (size_t)(row + 1) * DC + c8, c); else {
#pragma unroll
            for (int j = 0; j < 8; ++j) c[j] = 0.f; }
        ld8bf(gb + (size_t)row * DC + c8, g);
        { const F8 x = ld8(cw + c8), y = ld8(cw + DC + c8), z = ld8(cw + 2 * DC + c8); F8ARR(w0, x); F8ARR(w1, y); F8ARR(w2, z); }
#pragma unroll
        for (int j = 0; j < 8; ++j) g[j] *= (w0[j] * a[j] + w1[j] * b[j] + w2[j] * c[j]);
        st8bf(gb + (size_t)row * DC + c8, g);
    }
}

__device__ __forceinline__ void phase_scan(Ctx& C, int l) {
    LAS float* ag = (LAS float*)C.lds;
    for (int blk = C.bid; blk < 256; blk += C.G) {
        const int ci = blk * 32 + (C.tid & 31), seg = C.tid >> 5;
        const int p = ci & 63, g = (ci >> 6) & 31, dir = (ci >> 11) & 1, b = ci >> 12;
        const float* ap = WSP(float, WS_APOW) + ((((size_t)(l * 2 + dir) * NG + g) * 65 + 64) * NP + p) * 2;
        const float ar = ap[0], ai = ap[1];
        const float* sl = WSP(float, WS_SLOC) + (size_t)g * NCHP * 256 + dir * 128 + p;
        bf16_t* so = WSP(bf16_t, WS_SIN) + (size_t)g * NCHP * 256 + dir * 128 + p;
        float lr[16], li[16];
#pragma unroll
        for (int k = 0; k < 16; ++k) { const int kk = seg * 16 + k, ch = dir ? 256 * b + 255 - kk : 256 * b + kk; lr[k] = sl[(size_t)ch * 256] + sl[SLOC_HALF / 4 + (size_t)ch * 256]; li[k] = sl[(size_t)ch * 256 + 64] + sl[SLOC_HALF / 4 + (size_t)ch * 256 + 64]; }
        float xr = 0.f, xi = 0.f;
#pragma unroll
        for (int k = 0; k < 16; ++k) { const float nr = ar * xr - ai * xi + lr[k], ni = ar * xi + ai * xr + li[k]; xr = nr; xi = ni; }
        ag[((seg + 1) * 32 + (C.tid & 31)) * 2] = xr; ag[((seg + 1) * 32 + (C.tid & 31)) * 2 + 1] = xi;
        if (seg == 0) {
            float sr = 0.f, si = 0.f;
#pragma unroll
            for (int st = 0; st < 4; ++st) {
                const int ch = dir ? 512 + 4 * b + 3 - st : 512 + 4 * b + st;
                so[(size_t)ch * 256] = (bf16_t)f2bf(sr); so[(size_t)ch * 256 + 64] = (bf16_t)f2bf(si);
                const float cr = sl[(size_t)ch * 256] + sl[SLOC_HALF / 4 + (size_t)ch * 256], cim = sl[(size_t)ch * 256 + 64] + sl[SLOC_HALF / 4 + (size_t)ch * 256 + 64];
                const float nr = ar * sr - ai * si + cr, ni = ar * si + ai * sr + cim; sr = nr; si = ni;
            }
            ag[(C.tid & 31) * 2] = sr; ag[(C.tid & 31) * 2 + 1] = si;
        }
        __syncthreads();
        float a16r = ar, a16i = ai;
#pragma unroll
        for (int q = 0; q < 4; ++q) { const float nr = a16r * a16r - a16i * a16i, ni = 2.f * a16r * a16i; a16r = nr; a16i = ni; }
        float sr = ag[(C.tid & 31) * 2], si = ag[(C.tid & 31) * 2 + 1];
        for (int s2 = 0; s2 < seg; ++s2) {
            const float gr = ag[((s2 + 1) * 32 + (C.tid & 31)) * 2], gi = ag[((s2 + 1) * 32 + (C.tid & 31)) * 2 + 1];
            const float nr = a16r * sr - a16i * si + gr, ni = a16r * si + a16i * sr + gi; sr = nr; si = ni;
        }
#pragma unroll
        for (int k = 0; k < 16; ++k) {
            const int kk = seg * 16 + k, ch = dir ? 256 * b + 255 - kk : 256 * b + kk;
            so[(size_t)ch * 256] = (bf16_t)f2bf(sr); so[(size_t)ch * 256 + 64] = (bf16_t)f2bf(si);
            const float nr = ar * sr - ai * si + lr[k], ni = ar * si + ai * sr + li[k]; sr = nr; si = ni;
        }
        __syncthreads();
    }
}

__device__ __forceinline__ void phase_final(Ctx& C) {
    const int gw = C.bid * 8 + C.wave, NGW = C.G * 8;
    const float* fg = C.in[25];
    for (int row = gw; row < NLAT; row += NGW) {
        float* xr = C.out + (size_t)row * D; f32x4 x[4]; float q = 0.f;
#pragma unroll
        for (int j = 0; j < 4; ++j) { x[j] = *(const f32x4*)(xr + j * 256 + C.lane * 4); q += (x[j][0] * x[j][0] + x[j][1] * x[j][1]) + (x[j][2] * x[j][2] + x[j][3] * x[j][3]); }
        q = wave_sum(q); const float rs = rsqrtf(q * (1.0f / 1024.0f) + RMS_EPS);
#pragma unroll
        for (int j = 0; j < 4; ++j) { const f32x4 g = *(const f32x4*)(fg + j * 256 + C.lane * 4); *(f32x4*)(xr + j * 256 + C.lane * 4) = x[j] * rs * g; }
    }
}

template <class Epi>
__device__ __forceinline__ void gemm_plain(Ctx& C, const bf16_t* A, const bf16_t* Bt, int M, int N, int K, const Epi& E, int mode = 0, int kstride = 128) {
    pg8::Seg s; s.A = (const char*)A; s.B = (const char*)Bt; s.tA = 256 * K * 2; s.tB = 256 * K * 2; s.gA = 0; s.gB = 0; s.hA = 128 * K * 2; s.hB = 128 * K * 2; s.kA = kstride; s.kB = kstride;
    const pg8::Voff v = pg8::voff_plain(C.tid, K * 2, K * 2);
    pg8::Order S; S.init(M / 256, N / 256, 1, C.G, C.bid, K / 64, mode);
    pg8::gemm_phase<Epi, false>(C.lds, s, s, K / 64, v, v, S, E, C.tid);
}

constexpr int PH_PER_LAYER = 12, N_PHASES = 1 + DEPTH * PH_PER_LAYER + 1;

__global__ void __launch_bounds__(512, 2) mega(Args args) {
    extern __shared__ __attribute__((aligned(16))) unsigned char lds_raw[];
    Ctx C;
    C.in = args.in; C.out = args.out; C.ws = args.ws; C.lds = (LAS unsigned char*)lds_raw;
    C.G = gridDim.x; C.bid = blockIdx.x;
    const int wave0_ = __builtin_amdgcn_readfirstlane(threadIdx.x >> 6);
    volatile LAS unsigned* bst_ = (volatile LAS unsigned*)(C.lds + LDS_BYTES - 16);
    if (threadIdx.x == 0) { bst_[0] = 0u; bst_[1] = 0u; }
    __syncthreads();
    XcdBarrier xbar; xbar.bar = (unsigned*)(args.ws + WS_BAR); xbar.x = 0; xbar.st = bst_;
    if (args.coop) xbar = xcd_barrier_post((unsigned*)(args.ws + WS_BAR), bst_, (int)threadIdx.x);

#if PROBE_CLK
    const long long pc0_ = clock64(), pw0_ = wall_clock64();
#endif
    for (int ph = args.ph_lo; ph < args.ph_hi; ++ph) {
      const int nrep_ = (PROBE_SP == -1 ? (ph == 0) : (PROBE_SP >= 0 && ph >= 1 && ph < N_PHASES - 1 && (ph - 1) % PH_PER_LAYER == PROBE_SP)) ? 1 + PROBE_REP : 1;
      for (int rep_ = 0; rep_ < nrep_; ++rep_) {
        if (rep_ > 0 && args.coop) xcd_barrier(xbar, wave0_ * 64 + lane_id_v());
        { int t_ = wave0_ * 64 + lane_id_v(); asm volatile("" : "+v"(t_)); C.tid = t_; C.lane = t_ & 63; C.wave = wave0_; }
        if (ph == 0) phase_p0(C);
        else if (ph == N_PHASES - 1) phase_final(C);
        else {
            const int l = (ph - 1) / PH_PER_LAYER, sp = (ph - 1) % PH_PER_LAYER;
            unsigned char* wt = C.ws + WS_WT + (size_t)(l & 1) * WT_BYTES;
            const int MR = (l == DEPTH - 1) ? NLAT : TR;
            switch ((ONLY_SP >= 0) ? ONLY_SP : sp) {
            case 0: if (l == 0) phase_prep(C, 0, C.bid, C.G, 4 | 8 | 16 | 32 | 64 | 128 | 256 | 512 | 1024); break;
            case 1: phase_prep_b(C, l); break;
            case 2: {
                EpiIn E{WSP(float, WS_RSTD), WSP(float, WS_CIN), WSP(bf16_t, WS_GB), WSP(bf16_t, WS_V), WSP(bf16_t, WS_U), WSP(bf16_t, WS_SGA), WSP(bf16_t, WS_YB)};
                gemm_plain(C, WSP(bf16_t, WS_XS), (const bf16_t*)(wt + WT_IN), TR, DIN, D, E);
                if (rep_ == 0 && l + 1 < DEPTH && C.bid >= 32) phase_prep(C, l + 1, C.bid - 32, C.G - 32, 256);
            } break;
            case 3: {
                pg8::Seg s; s.A = (const char*)WSP(bf16_t, WS_U); s.B = (const char*)WSP(bf16_t, WS_WG + (size_t)(l & 1) * WG_BYTES);
                s.tA = 256 * 1024 * 2; s.gA = UROWS * 16 * 2; s.hA = 128 * 1024 * 2; s.kA = 128;
                s.tB = 0; s.gB = 256 * 1024 * 2; s.hB = 128 * 1024 * 2; s.kB = 128;
                const pg8::Voff v = pg8::voff_plain(C.tid, 2048, 2048);
                pg8::Order S; S.init(3, 1, NG, C.G, C.bid, 16, 2);
                EpiSloc E{WSP(float, WS_SLOC)};
                pg8::gemm_phase<EpiSloc, false>(C.lds, s, s, 16, v, v, S, E, C.tid);
                if (rep_ == 0 && l == DEPTH - 1) phase_conv(C, l, C.bid, C.G);
            } break;
            case 4: phase_scan(C, l); break;
            case 5: {
                pg8::Seg s0, s1;
                s0.A = (const char*)WSP(bf16_t, WS_U); s0.tA = 256 * 1024 * 2; s0.gA = UROWS * 16 * 2; s0.hA = 128 * 1024 * 2; s0.kA = 128;
                s0.B = (const char*)WSP(bf16_t, WS_KC + (size_t)(l & 1) * KC_BYTES) + 2 * 63 * 256 - 1536; s0.tB = 8192; s0.gB = 127 * 256 * 2; s0.hB = 4096; s0.kB = -2048;
                s1.A = (const char*)WSP(bf16_t, WS_SIN); s1.tA = 256 * 256 * 2; s1.gA = NCHP * 256 * 2; s1.hA = 128 * 256 * 2; s1.kA = 128;
                s1.B = (const char*)WSP(bf16_t, WS_MG + (size_t)(l & 1) * MG_BYTES); s1.tB = 256 * 256 * 2; s1.gB = 1024 * 256 * 2; s1.hB = 128 * 256 * 2; s1.kB = 128;
                pg8::Voff v0 = pg8::voff_plain(C.tid, 2048, 32), v1 = pg8::voff_plain(C.tid, 512, 512);
                {
                    int R, Cc; pg8::stage_rc(C.tid * 16, R, Cc); int Rb = (R & ~31) + pg8::perm32(R & 31);
                    v0.b0 = (unsigned)(Rb * 32 - (Cc >> 4) * 512 + (Cc & 15) * 2 + 1536);
                    pg8::stage_rc(C.tid * 16 + 8192, R, Cc); Rb = (R & ~31) + pg8::perm32(R & 31);
                    v0.b1 = (unsigned)(Rb * 32 - (Cc >> 4) * 512 + (Cc & 15) * 2 + 1536);
                }
                pg8::Order S; S.init(l == DEPTH - 1 ? 2 : 3, 4, NG, C.G, C.bid, 20);
                EpiSsm E{WSP(bf16_t, WS_U), C.in[19] + (size_t)l * DS, WSP(bf16_t, WS_S)};
                pg8::gemm_phase<EpiSsm, true>(C.lds, s0, s1, 16, v0, v1, S, E, C.tid);
                if (rep_ == 0 && l < DEPTH - 1 && C.bid >= 128) phase_conv(C, l, C.bid - 128, C.G - 128);
            } break;
            case 6: {
                EpiGlu E{C.in[21] + (size_t)l * 2048, WSP(bf16_t, WS_YB)};
                gemm_plain(C, WSP(bf16_t, WS_S), (const bf16_t*)(wt + WT_GLU), MR, 2048, DS, E);
                if (l + 1 < DEPTH && C.bid >= 16) phase_prep(C, l + 1, C.bid - 16, C.G - 16, 32 | 64 | 128);
            } break;
            case 7: {
                EpiMerge E{WSP(bf16_t, WS_SGA), WSP(bf16_t, WS_YB)};
                gemm_plain(C, WSP(bf16_t, WS_GB), (const bf16_t*)(wt + WT_OUTA), MR, D, DC, E);
            } break;
            case 8: {
                const float* gsv = WSP(float, WS_GSV) + (size_t)l * 4 * 3 * D;
                EpiRes<1, 0> E{C.out, WSP(float, WS_CTXX), gsv + 2 * 3 * D, gsv + 1 * 3 * D, WSP(bf16_t, WS_XS), WSP(float, WS_ROWSS)};
                gemm_plain(C, WSP(bf16_t, WS_YB), (const bf16_t*)(wt + WT_O), MR, D, D, E);
                if (l + 1 < DEPTH && C.bid >= 8) phase_prep(C, l + 1, C.bid - 8, C.G - 8, 4 | 8);
            } break;
            case 9: phase_rstd(C, MR); break;
            case 10: {
#if PROBE_EMPTY
                if (rep_ > 0 && PROBE_EMPTY <= 2) { EpiNone E0{WSP(float, WS_CIN)}; gemm_plain(C, WSP(bf16_t, WS_XS), (const bf16_t*)(wt + WT_FFIN), MR, 2 * DFF, D, E0, 0, PROBE_EMPTY == 2 ? 0 : 128); break; }
                if (rep_ > 0 && PROBE_EMPTY >= 3) { EpiFfT<PROBE_EMPTY> E0{WSP(float, WS_RSTD), WSP(float, WS_CFF), WSP(bf16_t, WS_HID)}; gemm_plain(C, WSP(bf16_t, WS_XS), (const bf16_t*)(wt + WT_FFIN), MR, 2 * DFF, D, E0); break; }
#endif
                EpiFf E{WSP(float, WS_RSTD), WSP(float, WS_CFF), WSP(bf16_t, WS_HID)};
                gemm_plain(C, WSP(bf16_t, WS_XS), (const bf16_t*)(wt + WT_FFIN), MR, 2 * DFF, D, E);
                if (rep_ == 0 && l + 1 < DEPTH && C.bid >= 44) phase_prep(C, l + 1, C.bid - 44, C.G - 44, 16 | 512);
            } break;
            case 11: {
                const int ln = l + 1 < DEPTH ? l + 1 : l;
                const float* gsv = WSP(float, WS_GSV);
                if (l + 1 < DEPTH) {
                    EpiRes<1, 1> E{C.out, WSP(float, WS_CTXX), gsv + ((size_t)l * 4 + 3) * 3 * D, gsv + ((size_t)ln * 4 + 0) * 3 * D, WSP(bf16_t, WS_XS), WSP(float, WS_ROWSS)};
                    gemm_plain(C, WSP(bf16_t, WS_HID), (const bf16_t*)(wt + WT_FFOUT), NLAT, D, DFF, E, 3);
                } else {
                    EpiRes<0, 0> E{C.out, WSP(float, WS_CTXX), gsv + ((size_t)l * 4 + 3) * 3 * D, gsv + ((size_t)ln * 4 + 0) * 3 * D, WSP(bf16_t, WS_XS), WSP(float, WS_ROWSS)};
                    gemm_plain(C, WSP(bf16_t, WS_HID), (const bf16_t*)(wt + WT_FFOUT), NLAT, D, DFF, E, 0);
                }
            } break;
            }
        }
      }
        const bool empty_ph_ = (ph >= 1 + PH_PER_LAYER && ph < N_PHASES - 1 && (ph - 1) % PH_PER_LAYER == 0);
        if (ph + 1 < args.ph_hi && args.coop && !empty_ph_) {
            if (ph + 2 == args.ph_hi) cg::this_grid().sync();
            else xcd_barrier(xbar, wave0_ * 64 + lane_id_v());
        }
    }
#if PROBE_CLK
    if (blockIdx.x == 0 && threadIdx.x == 0) { const long long pc1_ = clock64(), pw1_ = wall_clock64(); const long long mhz = (pc1_ - pc0_) * 100 / (pw1_ - pw0_); const long long extra_us = (mhz - 1000) * 2; if (extra_us > 0 && extra_us < 5000) { while (wall_clock64() - pw1_ < extra_us * 100) __builtin_amdgcn_s_sleep(8); } }
#endif
}

extern "C" void kernel_launch(void* const* d_in, const int* in_sizes, int n_in, void* d_out, int out_size, void* d_ws, size_t ws_size, hipStream_t stream) {
    static int grid = 0;
    if (grid == 0) {
        if (n_in != 26 || out_size != NLAT * D || ws_size < WS_END) { fprintf(stderr, "kernel_launch: unexpected shapes (n_in %d out %d ws %zu need %zu)\n", n_in, out_size, ws_size, (size_t)WS_END); grid = -1; return; }
        if (hipFuncSetAttribute((const void*)mega, hipFuncAttributeMaxDynamicSharedMemorySize, LDS_BYTES) != hipSuccess) { fprintf(stderr, "hipFuncSetAttribute failed\n"); grid = -1; return; }
        int dev = 0, cus = 0, per_cu = 0;
        hipGetDevice(&dev); hipDeviceGetAttribute(&cus, hipDeviceAttributeMultiprocessorCount, dev);
        hipOccupancyMaxActiveBlocksPerMultiprocessor(&per_cu, (const void*)mega, 512, LDS_BYTES);
        (void)hipGetLastError();
        if (per_cu < 1) fprintf(stderr, "occupancy query says %d blocks per CU\n", per_cu);
        grid = cus > 0 ? cus : 256;
    }
    if (grid < 0) return;
    Args a{};
    for (int i = 0; i < 26; ++i) a.in[i] = (const float*)d_in[i];
    a.out = (float*)d_out; a.ws = (unsigned char*)d_ws; a.pad = 0;
#if MK_COOP
    if (hipMemsetAsync((char*)d_ws + WS_BAR, 0, 16384, stream) != hipSuccess) { fprintf(stderr, "memset failed\n"); return; }
    a.ph_lo = 0; a.ph_hi = N_PHASES; a.coop = 1;
    void* kargs[] = {&a};
    hipError_t e = hipLaunchCooperativeKernel((const void*)mega, dim3(grid), dim3(512), kargs, LDS_BYTES, stream);
    if (e != hipSuccess) fprintf(stderr, "cooperative launch failed: %s (grid %d)\n", hipGetErrorString(e), grid);
#else
    for (int ph = 0; ph < N_PHASES; ++ph) {
        a.ph_lo = ph; a.ph_hi = ph + 1; a.coop = 0;
        hipLaunchKernelGGL(mega, dim3(grid), dim3(512), LDS_BYTES, stream, a);
    }
#endif
}
```

```cpp
#include <hip/hip_runtime.h>
#include <hip/hip_cooperative_groups.h>
#include <cstdio>
#include <cstdint>
namespace cg = cooperative_groups;

#ifndef PROBE_CLK
#define PROBE_CLK 0
#endif
#ifndef PROBE_TMASK
#define PROBE_TMASK 0
#endif
#ifndef PROBE_EMPTY
#define PROBE_EMPTY 0
#endif
#ifndef EPI_FENCE
#define EPI_FENCE
#endif
#ifndef ONLY_SP
#define ONLY_SP -1
#endif
#ifndef PROBE_SP
#define PROBE_SP -2
#endif
#define PROBE_REP 4
#ifndef MK_COOP
#define MK_COOP 1
#endif

#define LAS __attribute__((address_space(3)))
typedef unsigned short bf16_t;
typedef short bf16x8 __attribute__((ext_vector_type(8)));
typedef float f32x4 __attribute__((ext_vector_type(4)));
typedef unsigned u32x4 __attribute__((ext_vector_type(4)));

constexpr int D = 1024, SEQ = 16384, NLAT = 32768, CTXL = 256, NCTX = 512, TR = NLAT + NCTX  ;
constexpr int DEPTH = 4, DC = 512, DS = 512, NG = 32, NP = 64, DFF = 2816, DIN = 4096;
constexpr int NCH = TR / 64  , NCHP = NCH  , UROWS = TR;
constexpr float RMS_EPS = 1e-6f;

constexpr size_t al(size_t x) { return (x + 4095) & ~(size_t)4095; }
constexpr size_t WS_BAR = 0;
constexpr size_t WS_ROWSS = 16384;
constexpr size_t WS_RSTD = al(WS_ROWSS + (size_t)TR * 16 * 4);
constexpr size_t WS_MOD = al(WS_RSTD + (size_t)TR * 4);
constexpr size_t WS_GSV = al(WS_MOD + (size_t)4 * 3 * 6144 * 4);
constexpr size_t WS_CIN = al(WS_GSV + (size_t)4 * 4 * 3 * 1024 * 4);
constexpr size_t WS_CFF = al(WS_CIN + (size_t)3 * 4096 * 4);
constexpr size_t WS_APOW = al(WS_CFF + (size_t)3 * 5632 * 4);
constexpr size_t WS_BBAR = al(WS_APOW + (size_t)4 * 2 * 32 * 65 * 64 * 2 * 4);
constexpr size_t WS_KC = al(WS_BBAR + (size_t)4 * 2 * 32 * 64 * 16 * 2 * 4);
constexpr size_t KC_BYTES = al((size_t)32 * 127 * 256 * 2 + 8192), WG_BYTES = al((size_t)32 * 256 * 1024 * 2), MG_BYTES = al((size_t)32 * 1024 * 256 * 2);
constexpr size_t WS_WG = WS_KC + KC_BYTES;
constexpr size_t WS_MG = WS_WG + WG_BYTES;
constexpr size_t WS_SLOC = WS_MG + MG_BYTES;
constexpr size_t SLOC_HALF = al((size_t)32 * NCHP * 256 * 4);
constexpr size_t WS_SIN = WS_SLOC + 2 * SLOC_HALF;
constexpr size_t WS_CTXX = al(WS_SIN + (size_t)32 * NCHP * 256 * 2);
constexpr size_t WS_WT = al(WS_CTXX + (size_t)NCTX * D * 4);
constexpr size_t WT_IN = 0, WT_OUTA = WT_IN + (size_t)DIN * D * 2, WT_GLU = WT_OUTA + (size_t)D * DC * 2, WT_O = WT_GLU + (size_t)2048 * DS * 2,
                 WT_FFIN = WT_O + (size_t)D * D * 2, WT_FFOUT = WT_FFIN + (size_t)2 * DFF * D * 2, WT_END = WT_FFOUT + (size_t)D * DFF * 2;
constexpr size_t WT_BYTES = al(WT_END);
constexpr size_t WS_XS = WS_WT + WT_BYTES;
constexpr size_t WS_XB = al(WS_XS + (size_t)TR * D * 2);
constexpr size_t WS_YB = al(WS_XB + (size_t)NLAT * D * 2);
constexpr size_t WS_GB = al(WS_YB + (size_t)TR * D * 2);
constexpr size_t WS_V = al(WS_GB + (size_t)TR * DC * 2);
constexpr size_t WS_U = al(WS_V + (size_t)TR * DC * 2);
constexpr size_t WS_S = al(WS_U + (size_t)NG * UROWS * 16 * 2);
constexpr size_t WS_SGA = al(WS_S + (size_t)TR * DS * 2);
constexpr size_t WS_OVL_END = al(WS_SGA + (size_t)TR * D * 2);
constexpr size_t WS_HID = WS_GB;
static_assert(WS_HID + (size_t)TR * DFF * 2 <= WS_OVL_END, "hid overlay");
constexpr size_t WS_END = WS_OVL_END;
static_assert(WS_END <= (size_t)512 * 1024 * 1024, "workspace");

constexpr int LDS_BYTES = 147456;

__device__ __forceinline__ int lane_id_v() { int l; asm volatile("v_mbcnt_lo_u32_b32 %0, -1, 0\n\tv_mbcnt_hi_u32_b32 %0, -1, %0" : "=v"(l)); return l; }
__device__ __forceinline__ unsigned f2bf(float f) { unsigned u = __builtin_bit_cast(unsigned, f); return (u + 0x7fffu + ((u >> 16) & 1u)) >> 16; }
__device__ __forceinline__ unsigned pk2(float lo, float hi) { unsigned r; asm("v_cvt_pk_bf16_f32 %0, %1, %2" : "=v"(r) : "v"(lo), "v"(hi)); return r; }
__device__ __forceinline__ float bflo(unsigned w) { return __builtin_bit_cast(float, w << 16); }
__device__ __forceinline__ float bfhi(unsigned w) { return __builtin_bit_cast(float, w & 0xffff0000u); }
__device__ __forceinline__ float sigm(float x) { return __builtin_amdgcn_rcpf(1.0f + __expf(-x)); }
__device__ __forceinline__ float shfl_xor_f(float v, int o) { return __builtin_bit_cast(float, __builtin_amdgcn_ds_bpermute((lane_id_v() ^ o) << 2, __builtin_bit_cast(int, v))); }
__device__ __forceinline__ float wave_sum(float v) {
#pragma unroll
    for (int o = 1; o < 64; o <<= 1) v += shfl_xor_f(v, o);
    return v;
}
__device__ __forceinline__ void sincos_cw(float x, float& s, float& c) {
    const float q = rintf(x * 0.63661977236758134f);
    float r = fmaf(-q, 1.5703125f, x);
    r = fmaf(-q, 4.837512969970703125e-4f, r);
    r = fmaf(-q, 7.54978995489188e-8f, r);
    const float r2 = r * r;
    float sp = fmaf(r2, 2.7557319e-6f, -1.9841270e-4f); sp = fmaf(sp, r2, 8.3333333e-3f); sp = fmaf(sp, r2, -1.6666667e-1f); sp = fmaf(sp * r2, r, r);
    float cp = fmaf(r2, -2.7557319e-7f, 2.4801587e-5f); cp = fmaf(cp, r2, -1.3888889e-3f); cp = fmaf(cp, r2, 4.1666667e-2f); cp = fmaf(cp, r2, -0.5f); cp = fmaf(cp, r2, 1.0f);
    const int qi = (int)q & 3;
    const float ss = (qi & 1) ? cp : sp, cc = (qi & 1) ? sp : cp;
    s = (qi & 2) ? -ss : ss; c = ((qi + 1) & 2) ? -cc : cc;
}


#define XB_TMO      128
#define XB_XCNT(j)  (256  + 64 * (j))
#define XB_XSUB(j)  (1280 + 64 * (j))
#define XB_XGEN(j)  (2304 + 64 * (j))
#define XB_TOP      3328
#define XB_TOPGEN   3392
#define XCD_BAR_WORDS 3456
#define XB_SPIN_CAP (1u << 18)
__device__ __forceinline__ unsigned xb_ld(unsigned* p)              { return __hip_atomic_load(p, __ATOMIC_RELAXED, __HIP_MEMORY_SCOPE_AGENT); }
__device__ __forceinline__ unsigned xb_add(unsigned* p, unsigned v) { return __hip_atomic_fetch_add(p, v, __ATOMIC_RELAXED, __HIP_MEMORY_SCOPE_AGENT); }
__device__ __forceinline__ unsigned xb_xcc_id() { return (unsigned)__builtin_amdgcn_s_getreg((3 << 11) | 20) & 0xFu; }
#define XB_SPIN(cond, bar) do { unsigned _sp = 0; while (cond) { __builtin_amdgcn_s_sleep(1); \
    if ((++_sp & 255u) == 0u) { if (xb_ld(&(bar)[XB_TMO])) break; if (_sp > XB_SPIN_CAP) { atomicAdd(&(bar)[XB_TMO], 1u); break; } } } } while (0)
struct XcdBarrier { unsigned* bar; unsigned x; volatile LAS unsigned* st; };
__device__ __forceinline__ XcdBarrier xcd_barrier_post(unsigned* bar, volatile LAS unsigned* st, int tid) {
    XcdBarrier b; b.bar = bar; b.x = xb_xcc_id(); b.st = st;
    if (tid == 0) (void)xb_add(&bar[XB_XCNT(b.x)], 1u);
    return b;
}
__device__ __forceinline__ void xcd_barrier_complete(unsigned* bar, unsigned x, unsigned& nloc, unsigned& nx) {
    const unsigned G = gridDim.x * gridDim.y * gridDim.z;
    unsigned sum, cnt, mine, sp = 0u;
    for (;;) {
        sum = 0u; cnt = 0u; mine = 0u;
#pragma unroll
        for (unsigned j = 0; j < 16; ++j) { const unsigned c = xb_ld(&bar[XB_XCNT(j)]); sum += c; cnt += (c > 0u) ? 1u : 0u; mine = (j == x) ? c : mine; }
        if (sum == G) break;
        __builtin_amdgcn_s_sleep(1);
        if ((++sp & 255u) == 0u) { if (xb_ld(&bar[XB_TMO])) break; if (sp > XB_SPIN_CAP) { atomicAdd(&bar[XB_TMO], 1u); break; } }
    }
    nloc = mine > 0u ? mine : 1u; nx = cnt > 0u ? cnt : 1u;
}
__device__ __forceinline__ void xcd_barrier(const XcdBarrier& b, int tid) {
    asm volatile("s_waitcnt vmcnt(0)" ::: "memory");
    __syncthreads();
    if (tid == 0) {
        unsigned* bar = b.bar;
        __builtin_amdgcn_s_waitcnt(0);
        unsigned nloc = b.st[0], nx = b.st[1];
        if (nloc == 0u) { xcd_barrier_complete(bar, b.x, nloc, nx); b.st[0] = nloc; b.st[1] = nx; }
        const unsigned old = xb_add(&bar[XB_XSUB(b.x)], 1u);
        const unsigned gen = old / nloc;
        if (old + 1u == (gen + 1u) * nloc) {
            __builtin_amdgcn_fence(__ATOMIC_RELEASE, "agent");
            asm volatile("s_waitcnt vmcnt(0)" ::: "memory");
            const unsigned og = xb_add(&bar[XB_TOP], 1u);
            const unsigned tg = og / nx;
            if (og + 1u == (tg + 1u) * nx) xb_add(&bar[XB_TOPGEN], 1u);
            else XB_SPIN(xb_ld(&bar[XB_TOPGEN]) == tg, bar);
            __builtin_amdgcn_fence(__ATOMIC_ACQUIRE, "agent");
            xb_add(&bar[XB_XGEN(b.x)], 1u);
            asm volatile("s_waitcnt vmcnt(0)" ::: "memory");
        } else {
            XB_SPIN(xb_ld(&bar[XB_XGEN(b.x)]) == gen, bar);
            __builtin_amdgcn_fence(__ATOMIC_ACQUIRE, "agent");
            asm volatile("s_waitcnt vmcnt(0)" ::: "memory");
        }
    }
    __syncthreads();
}

namespace pg8 {
constexpr int BM = 256, BK = 64, HALF = 128, HTB = HALF * BK * 2, STAGE_BYTES = 8 * HTB, NXCD = 8, WGM = 8;
__host__ __device__ __forceinline__ int lds_byte(int r, int c) { const int st = (r >> 4) * 2 + (c >> 5), rr = r & 15, cc = c & 31, ob = rr * 64 + cc * 2; return st * 1024 + (ob ^ (((ob >> 9) & 1) << 5)); }
__host__ __device__ __forceinline__ void stage_rc(int b, int& R, int& C) { const int st = b / 1024, sb = b % 1024, swz = sb ^ (((sb >> 9) & 1) << 5); R = (st >> 1) * 16 + swz / 64; C = (st & 1) * 32 + (swz % 64) / 2; }
__host__ __device__ __forceinline__ int perm32(int rho) { const int n = rho >> 4, i = rho & 15; return 8 * (i >> 2) + 4 * n + (i & 3); }

struct Unit { int pm, pn, g, ko, nt; };
struct Seg { const char* A; const char* B; int tA, tB, gA, gB, hA, hB, kA, kB; };

struct Order {
    int nM, nN, nwg, G, c, mode, nt;
    __device__ void init(int nM_, int nN_, int nG_, int G_, int c_, int nt_, int mode_ = -1) {
        nM = nM_; nN = nN_; mode = mode_ >= 0 ? mode_ : (nG_ > 1 ? 1 : 0); nt = nt_; G = G_; c = c_;
        nwg = nM * nN * nG_ * (mode == 2 ? 2 : 1) + (mode == 3 ? 32 : 0); }
    __device__ bool next(int i, Unit& u) const {
        long L = (long)i * G + c; if (L >= nwg) return false;
        u.ko = 0; u.nt = nt;
        if (mode == 1) { const int per = nM * nN; u.g = (int)L / per; const int r = (int)L % per; u.pm = r % nM; u.pn = r / nM; return true; }
        if (mode == 2) { const int h = (int)L & 1, L2 = (int)L >> 1; u.g = L2 / nM; u.pm = L2 % nM; u.pn = 0; u.ko = h * (nt / 2); u.nt = nt / 2; return true; }
        int nw = nwg;
        if (mode == 3) {
            if (L < 32) { const int sp = (int)L & 3, t8 = (int)L >> 2; u.g = sp; u.pm = 128 + (t8 >> 2); u.pn = t8 & 3;
                if (nt == 44) { u.ko = sp == 0 ? 0 : (sp == 1 ? 12 : (sp == 2 ? 24 : 34)); u.nt = sp < 2 ? 12 : 10; } else { u.ko = sp * (nt >> 2); u.nt = nt >> 2; }
                return true; }
            L -= 32; nw -= 32; }
        int wgid = (int)L; { const int q = nw / NXCD, r = nw % NXCD, xcd = wgid % NXCD, off = wgid / NXCD; wgid = (xcd < r ? xcd * (q + 1) : r * (q + 1) + (xcd - r) * q) + off; }
        const int nig = WGM * nN, gid = wgid / nig, fm = gid * WGM, gsz = (nM - fm) < WGM ? (nM - fm) : WGM;
        u.pm = fm + ((wgid % nig) % gsz); u.pn = (wgid % nig) / gsz; u.g = 0; return true;
    }
};

struct Voff { unsigned a0, a1, b0, b1; };
__device__ __forceinline__ Voff voff_plain(int tid, int ldaB, int ldbB) {
    Voff v; int R, C;
    stage_rc(tid * 16, R, C); { const int Rb = (R & ~31) + perm32(R & 31); v.a0 = (unsigned)(R * ldaB + C * 2); v.b0 = (unsigned)(Rb * ldbB + C * 2); }
    stage_rc(tid * 16 + 8192, R, C); { const int Rb = (R & ~31) + perm32(R & 31); v.a1 = (unsigned)(R * ldaB + C * 2); v.b1 = (unsigned)(Rb * ldbB + C * 2); }
    return v;
}

#define EPI_ARGS const f32x4 (&acc)[2][2][4][2], const pg8::Unit& u, int wr, int wc, int fr, int fq
#define EPI_OPAQUE asm volatile("" : "+v"(fr), "+v"(fq))

template <class Epi, bool TWOSEG>
__device__ __forceinline__ void gemm_phase(LAS unsigned char* lds, const Seg s0, const Seg s1, const int nt0, const Voff v0_in, const Voff v1_in, const Order& S, const Epi& E, const int tid) {
    const int wid = __builtin_amdgcn_readfirstlane(tid >> 6), lane = tid & 63, wr = wid >> 2, wc = wid & 3, fr = lane & 15, fq = lane >> 4;
    const unsigned ldsw = (unsigned)wid * 1024u;
    const int aoff = lds_byte(wr * 64 + fr, fq * 8), boff = lds_byte(wc * 32 + fr, fq * 8);
#define PG8_SA(b, h) (((b) * 2 + (h)) * HTB)
#define PG8_SB(b, h) ((4 + (b) * 2 + (h)) * HTB)
#define PG8_SEG1(t) (TWOSEG && (t) >= nt0)
#define PG8_UA(u, t) (PG8_SEG1(t) ? (s1.A + (long long)((u).g * s1.gA + (u).pm * s1.tA + ((t) - nt0) * s1.kA)) : (s0.A + (long long)((u).g * s0.gA + (u).pm * s0.tA + ((t) + (u).ko) * s0.kA)))
#define PG8_UB(u, t) (PG8_SEG1(t) ? (s1.B + (long long)((u).g * s1.gB + (u).pn * s1.tB + ((t) - nt0) * s1.kB)) : (s0.B + (long long)((u).g * s0.gB + (u).pn * s0.tB + ((t) + (u).ko) * s0.kB)))
#define PG8_HA(t) (PG8_SEG1(t) ? s1.hA : s0.hA)
#define PG8_HB(t) (PG8_SEG1(t) ? s1.hB : s0.hB)
#define PG8_STG(bufoff, gptr, o0, o1) do { \
        __builtin_amdgcn_global_load_lds((const unsigned*)((gptr) + (o0)), (LAS unsigned*)(lds + (bufoff) + ldsw), 16, 0, 0); \
        __builtin_amdgcn_global_load_lds((const unsigned*)((gptr) + (o1)), (LAS unsigned*)(lds + (bufoff) + ldsw + 8192), 16, 0, 0); } while (0)
#define PG8_STG_A(bufoff, gptr, t) do { const bool s_ = PG8_SEG1(t); PG8_STG(bufoff, gptr, s_ ? v1.a0 : v0.a0, s_ ? v1.a1 : v0.a1); } while (0)
#define PG8_STG_B(bufoff, gptr, t) do { const bool s_ = PG8_SEG1(t); PG8_STG(bufoff, gptr, s_ ? v1.b0 : v0.b0, s_ ? v1.b1 : v0.b1); } while (0)
#define PG8_LDA(dst, b, h) do { _Pragma("unroll") for (int m = 0; m < 4; ++m) _Pragma("unroll") for (int k = 0; k < 2; ++k) dst[m][k] = *(const LAS bf16x8*)(lds + PG8_SA(b, h) + aoff + m * 2048 + k * 1024); } while (0)
#define PG8_LDB(dst, b, h) do { _Pragma("unroll") for (int n = 0; n < 2; ++n) _Pragma("unroll") for (int k = 0; k < 2; ++k) dst[n][k] = *(const LAS bf16x8*)(lds + PG8_SB(b, h) + boff + n * 2048 + k * 1024); } while (0)
#define PG8_MMA(ai, bj, At, Bt) do { __builtin_amdgcn_s_setprio(1); _Pragma("unroll") for (int m = 0; m < 4; ++m) _Pragma("unroll") for (int n = 0; n < 2; ++n) _Pragma("unroll") for (int k = 0; k < 2; ++k) \
        acc[ai][bj][m][n] = __builtin_amdgcn_mfma_f32_16x16x32_bf16(Bt[n][k], At[m][k], acc[ai][bj][m][n], 0, 0, 0); __builtin_amdgcn_s_setprio(0); } while (0)
#define PG8_WAIT_V(n) asm volatile("s_waitcnt vmcnt(" #n ")" ::: "memory")
#define PG8_WAIT_L(n) asm volatile("s_waitcnt lgkmcnt(" #n ")" ::: "memory")
#define PG8_BAR __builtin_amdgcn_s_barrier()
#define PG8_SCHED __builtin_amdgcn_sched_barrier(0)
    Unit cur, nxt; int ui = 0;
    if (!S.next(0, cur)) return;
    f32x4 acc[2][2][4][2];
#pragma unroll
    for (int a = 0; a < 2; ++a)
#pragma unroll
        for (int b = 0; b < 2; ++b)
#pragma unroll
            for (int m = 0; m < 4; ++m)
#pragma unroll
                for (int n = 0; n < 2; ++n) acc[a][b][m][n] = (f32x4){0.f, 0.f, 0.f, 0.f};
    bf16x8 At[4][2], B0[2][2], B1[2][2];
    Voff v0 = v0_in, v1 = v1_in;
    asm volatile("" : "+v"(v0.a0), "+v"(v0.a1), "+v"(v0.b0), "+v"(v0.b1));
    if (TWOSEG) asm volatile("" : "+v"(v1.a0), "+v"(v1.a1), "+v"(v1.b0), "+v"(v1.b1));
    {
        const char* cA0 = PG8_UA(cur, 0); const char* cB0 = PG8_UB(cur, 0); const char* cA1 = PG8_UA(cur, 1); const char* cB1 = PG8_UB(cur, 1);
        PG8_STG_B(PG8_SB(0, 0), cB0, 0); PG8_STG_A(PG8_SA(0, 0), cA0, 0); PG8_STG_B(PG8_SB(0, 1), cB0 + PG8_HB(0), 0); PG8_STG_A(PG8_SA(0, 1), cA0 + PG8_HA(0), 0);
        if (wr == 1) PG8_BAR;
        PG8_WAIT_V(4); PG8_BAR;
        PG8_STG_B(PG8_SB(1, 0), cB1, 1); PG8_STG_A(PG8_SA(1, 0), cA1, 1); PG8_STG_B(PG8_SB(1, 1), cB1 + PG8_HB(1), 1);
        PG8_WAIT_V(6); PG8_BAR;
    }
    for (;;) {
        const bool has_next = S.next(ui + 1, nxt);
        Unit nu; nu.pm = has_next ? nxt.pm : cur.pm; nu.pn = has_next ? nxt.pn : cur.pn; nu.g = has_next ? nxt.g : cur.g; nu.ko = has_next ? nxt.ko : cur.ko; nu.nt = 0;
        int nt = cur.nt; asm volatile("" : "+s"(nt));
#pragma clang loop unroll(disable)
        for (int t = 0; t < nt; t += 2) {
            const bool last = (t == nt - 2);
            const int t1 = t + 1, t2 = last ? 0 : t + 2, t3 = t2 + 1;
            Unit u2; u2.pm = last ? nu.pm : cur.pm; u2.pn = last ? nu.pn : cur.pn; u2.g = last ? nu.g : cur.g; u2.ko = last ? nu.ko : cur.ko; u2.nt = 0;
            const char* a1 = PG8_UA(cur, t1);
            const char* a2 = PG8_UA(u2, t2); const char* b2 = PG8_UB(u2, t2);
            const char* a3 = PG8_UA(u2, t3); const char* b3 = PG8_UB(u2, t3);
            PG8_LDB(B0, 0, 0); PG8_SCHED; PG8_LDA(At, 0, 0); PG8_STG_A(PG8_SA(1, 1), a1 + PG8_HA(t1), t1);
            PG8_WAIT_L(8); PG8_BAR; PG8_WAIT_L(0); PG8_MMA(0, 0, At, B0); PG8_BAR; PG8_SCHED;
            PG8_LDB(B1, 0, 1); PG8_STG_B(PG8_SB(0, 0), b2, t2);
            PG8_BAR; PG8_WAIT_L(0); PG8_MMA(0, 1, At, B1); PG8_BAR;
            PG8_LDA(At, 0, 1); PG8_STG_A(PG8_SA(0, 0), a2, t2);
            PG8_BAR; PG8_WAIT_L(0); PG8_MMA(1, 0, At, B0); PG8_BAR; PG8_SCHED;
            PG8_STG_B(PG8_SB(0, 1), b2 + PG8_HB(t2), t2);
            PG8_WAIT_V(6); PG8_BAR; PG8_MMA(1, 1, At, B1); PG8_BAR;
            PG8_LDB(B0, 1, 0); PG8_SCHED; PG8_LDA(At, 1, 0); PG8_STG_A(PG8_SA(0, 1), a2 + PG8_HA(t2), t2);
            PG8_WAIT_L(8); PG8_BAR; PG8_WAIT_L(0); PG8_MMA(0, 0, At, B0); PG8_BAR; PG8_SCHED;
            PG8_LDB(B1, 1, 1); PG8_STG_B(PG8_SB(1, 0), b3, t3);
            PG8_BAR; PG8_WAIT_L(0); PG8_MMA(0, 1, At, B1); PG8_BAR;
            PG8_LDA(At, 1, 1); PG8_STG_A(PG8_SA(1, 0), a3, t3);
            PG8_BAR; PG8_WAIT_L(0); PG8_MMA(1, 0, At, B0); PG8_BAR; PG8_SCHED;
            PG8_STG_B(PG8_SB(1, 1), b3 + PG8_HB(t3), t3);
            PG8_WAIT_V(6); PG8_BAR; PG8_MMA(1, 1, At, B1); PG8_BAR;
        }
        { const int l2_ = lane_id_v(); E(acc, cur, wr, wc, l2_ & 15, l2_ >> 4); }
        if (!has_next) break;
#pragma unroll
        for (int a = 0; a < 2; ++a)
#pragma unroll
            for (int b = 0; b < 2; ++b)
#pragma unroll
                for (int m = 0; m < 4; ++m)
#pragma unroll
                    for (int n = 0; n < 2; ++n) acc[a][b][m][n] = (f32x4){0.f, 0.f, 0.f, 0.f};
        cur = nxt; ++ui;
    }
    PG8_WAIT_V(0);
    if (wr == 0) PG8_BAR;
    PG8_BAR;
#undef PG8_SA
#undef PG8_SB
#undef PG8_SEG1
#undef PG8_UA
#undef PG8_UB
#undef PG8_HA
#undef PG8_HB
#undef PG8_STG
#undef PG8_STG_A
#undef PG8_STG_B
#undef PG8_LDA
#undef PG8_LDB
#undef PG8_MMA
#undef PG8_WAIT_V
#undef PG8_WAIT_L
#undef PG8_BAR
#undef PG8_SCHED
}
}

struct Args { const float* in[26]; float* out; unsigned char* ws; int ph_lo, ph_hi, coop, pad; };

struct Ctx {
    const float* const* in; float* out; unsigned char* ws; LAS unsigned char* lds;
    int tid, lane, wave, G, bid;
};
#define WSP(T, off) ((T*)(C.ws + (off)))
#define REFRESH_TID(C) do { const int t__ = (C).wave * 64 + lane_id_v(); (C).tid = t__; (C).lane = t__ & 63; } while (0)
__device__ __forceinline__ int sid_of_pm(int pm) { return pm < 64 ? 0 : (pm < 128 ? 1 : 2); }
__device__ __forceinline__ int sid_of_row(int r) { return r < SEQ ? 0 : (r < NLAT ? 1 : 2); }

struct F8 { f32x4 lo, hi; };
__device__ __forceinline__ F8 ld8(const float* p) { F8 r; r.lo = *(const f32x4*)p; r.hi = *(const f32x4*)(p + 4); return r; }
__device__ __forceinline__ void st8bf(bf16_t* p, const float (&v)[8]) { u32x4 w; w.x = pk2(v[0], v[1]); w.y = pk2(v[2], v[3]); w.z = pk2(v[4], v[5]); w.w = pk2(v[6], v[7]); *(u32x4*)p = w; }
__device__ __forceinline__ void ld8bf(const bf16_t* p, float (&v)[8]) { const u32x4 w = *(const u32x4*)p; v[0] = bflo(w.x); v[1] = bfhi(w.x); v[2] = bflo(w.y); v[3] = bfhi(w.y); v[4] = bflo(w.z); v[5] = bfhi(w.z); v[6] = bflo(w.w); v[7] = bfhi(w.w); }
#define ACC8(dst, ai, bj, m) do { _Pragma("unroll") for (int j_ = 0; j_ < 4; ++j_) { dst[j_] = acc[ai][bj][m][0][j_]; dst[4 + j_] = acc[ai][bj][m][1][j_]; } } while (0)
#define F8ARR(dst, f) do { _Pragma("unroll") for (int j_ = 0; j_ < 4; ++j_) { dst[j_] = (f).lo[j_]; dst[4 + j_] = (f).hi[j_]; } } while (0)
__device__ __forceinline__ float rstd_of(const float* rowss, int row) {
    const f32x4* p = (const f32x4*)(rowss + (size_t)row * 16); const f32x4 a = p[0], b = p[1], c = p[2], d = p[3];
    const float s = ((a[0] + a[1]) + (a[2] + a[3])) + ((b[0] + b[1]) + (b[2] + b[3])) + ((c[0] + c[1]) + (c[2] + c[3])) + ((d[0] + d[1]) + (d[2] + d[3]));
    return rsqrtf(s * (1.0f / 1024.0f) + RMS_EPS);
}

struct EpiIn {
    const float* rowss; const float* cin; bf16_t *gb, *v, *uu, *sga, *sgb;
    __device__ __forceinline__ void operator()(EPI_ARGS) const {
        EPI_OPAQUE;
        const int sid = sid_of_pm(u.pm), lc = wc * 32 + 8 * fq, pn = u.pn;
        float c0[8], c1[8];
        { const F8 a = ld8(cin + sid * DIN + pn * 256 + lc), b = ld8(cin + sid * DIN + pn * 256 + 128 + lc); F8ARR(c0, a); F8ARR(c1, b); }
#pragma unroll
        for (int ai = 0; ai < 2; ++ai)
#pragma unroll
            for (int m = 0; m < 4; ++m) {
                const int row = u.pm * 256 + ai * 128 + wr * 64 + m * 16 + fr;
                const float rs = rowss[row];
                float z0[8], z1[8]; ACC8(z0, ai, 0, m); ACC8(z1, ai, 1, m);
#pragma unroll
                for (int j = 0; j < 8; ++j) { z0[j] = fmaf(rs, z0[j], c0[j]); z1[j] = fmaf(rs, z1[j], c1[j]); }
                if (pn < 2) { st8bf(gb + (size_t)row * DC + pn * 256 + lc, z0); st8bf(gb + (size_t)row * DC + pn * 256 + 128 + lc, z1); }
                else if (pn < 6) {
#pragma unroll
                    for (int j = 0; j < 8; ++j) z0[j] *= z1[j];
                    st8bf(v + (size_t)row * DC + (pn - 2) * 128 + lc, z0); }
                else if (pn < 8) {
                    const int col0 = (pn - 6) * 256 + lc, col1 = col0 + 128;
                    st8bf(uu + ((size_t)(col0 >> 4) * UROWS + row) * 16 + (col0 & 8), z0);
                    st8bf(uu + ((size_t)(col1 >> 4) * UROWS + row) * 16 + (col1 & 8), z1); }
                else {
#pragma unroll
                    for (int j = 0; j < 8; ++j) { z0[j] = sigm(z0[j]); z1[j] = sigm(z1[j]); }
                    bf16_t* dst = (pn < 12) ? (sga + (size_t)row * D + (pn - 8) * 256 + lc) : (sgb + (size_t)row * D + (pn - 12) * 256 + lc);
                    st8bf(dst, z0); st8bf(dst + 128, z1); }
                EPI_FENCE;
            }
    }
};
struct EpiSloc {
    float* sloc;
    __device__ __forceinline__ void operator()(EPI_ARGS) const {
        EPI_OPAQUE;
        const int lc = wc * 32 + 8 * fq;
#pragma unroll
        for (int ai = 0; ai < 2; ++ai)
#pragma unroll
            for (int m = 0; m < 4; ++m) {
                const int ch = u.pm * 256 + ai * 128 + wr * 64 + m * 16 + fr;
                if (ch < NCH) {
                    float* dst = sloc + (u.ko ? SLOC_HALF / 4 : 0) + ((size_t)u.g * NCHP + ch) * 256 + lc;
                    *(f32x4*)(dst) = acc[ai][0][m][0]; *(f32x4*)(dst + 4) = acc[ai][0][m][1];
                    *(f32x4*)(dst + 128) = acc[ai][1][m][0]; *(f32x4*)(dst + 132) = acc[ai][1][m][1]; }
                EPI_FENCE;
            }
    }
};
struct EpiSsm {
    const bf16_t* uu; const float* dskip; bf16_t* s;
    __device__ __forceinline__ void operator()(EPI_ARGS) const {
        EPI_OPAQUE;
        const int lc = wc * 32 + 8 * fq;
#pragma unroll
        for (int bj = 0; bj < 2; ++bj) {
            const int n = u.pn * 256 + bj * 128 + lc, t = n >> 4, hh = n & 8;
            float dk[8]; { const F8 a = ld8(dskip + u.g * 16 + hh); F8ARR(dk, a); }
#pragma unroll
            for (int ai = 0; ai < 2; ++ai)
#pragma unroll
                for (int m = 0; m < 4; ++m) {
                    const int ch = u.pm * 256 + ai * 128 + wr * 64 + m * 16 + fr;
                    if (ch < NCH) {
                        const int tok = ch * 64 + t;
                        float y[8], uv[8]; ACC8(y, ai, bj, m); ld8bf(uu + ((size_t)u.g * UROWS + tok) * 16 + hh, uv);
#pragma unroll
                        for (int j = 0; j < 8; ++j) { const float x = fmaf(dk[j], uv[j], y[j]); y[j] = x * sigm(1.5957691216f * (x + 0.044715f * x * x * x)); }
                        st8bf(s + (size_t)tok * DS + u.g * 16 + hh, y); }
                    EPI_FENCE;
                }
        }
    }
};
struct EpiGlu {
    const float* bglu; bf16_t* yb;
    __device__ __forceinline__ void operator()(EPI_ARGS) const {
        EPI_OPAQUE;
        const int lc = wc * 32 + 8 * fq, col = u.pn * 128 + lc;
        float bv[8], bg[8]; { const F8 a = ld8(bglu + col), b = ld8(bglu + 1024 + col); F8ARR(bv, a); F8ARR(bg, b); }
#pragma unroll
        for (int ai = 0; ai < 2; ++ai)
#pragma unroll
            for (int m = 0; m < 4; ++m) {
                const int row = u.pm * 256 + ai * 128 + wr * 64 + m * 16 + fr;
                float vv[8], gg[8], sg[8]; ACC8(vv, ai, 0, m); ACC8(gg, ai, 1, m);
                bf16_t* p = yb + (size_t)row * D + col; ld8bf(p, sg);
#pragma unroll
                for (int j = 0; j < 8; ++j) vv[j] = sg[j] * (vv[j] + bv[j]) * sigm(gg[j] + bg[j]);
                st8bf(p, vv);
                EPI_FENCE;
            }
    }
};
struct EpiMerge {
    const bf16_t* sga; bf16_t* yb;
    __device__ __forceinline__ void operator()(EPI_ARGS) const {
        EPI_OPAQUE;
        const int lc = wc * 32 + 8 * fq;
#pragma unroll
        for (int ai = 0; ai < 2; ++ai)
#pragma unroll
            for (int m = 0; m < 4; ++m) {
                const int row = u.pm * 256 + ai * 128 + wr * 64 + m * 16 + fr;
#pragma unroll
                for (int bj = 0; bj < 2; ++bj) {
                    const size_t o = (size_t)row * D + u.pn * 256 + bj * 128 + lc;
                    float ya[8], a[8], b[8]; ACC8(ya, ai, bj, m); ld8bf(sga + o, a); ld8bf(yb + o, b);
#pragma unroll
                    for (int j = 0; j < 8; ++j) ya[j] = fmaf(a[j], ya[j], b[j]);
                    st8bf(yb + o, ya); }
                EPI_FENCE;
            }
    }
};
template <int emit, int ctx_atomic>
struct EpiRes {
    bf16_t* xb; float* slab; const float* gate; const float* gsn; bf16_t* xs; float* rowss;
    __device__ __forceinline__ void operator()(EPI_ARGS) const {
        EPI_OPAQUE;
        const int sid = sid_of_pm(u.pm), lc = wc * 32 + 8 * fq;
        if (ctx_atomic && u.pm >= 128) {
#pragma unroll
            for (int bj = 0; bj < 2; ++bj) {
                const int col = u.pn * 256 + bj * 128 + lc;
                float gt[8]; { const F8 a = ld8(gate + sid * D + col); F8ARR(gt, a); }
#pragma unroll
                for (int ai = 0; ai < 2; ++ai)
#pragma unroll
                    for (int m = 0; m < 4; ++m) {
                        const int row = u.pm * 256 + ai * 128 + wr * 64 + m * 16 + fr;
                        float* xp = slab + ((size_t)u.g * NCTX + (row - NLAT)) * D + col;
                        float y[8]; ACC8(y, ai, bj, m);
                        *(f32x4*)xp = (f32x4){gt[0] * y[0], gt[1] * y[1], gt[2] * y[2], gt[3] * y[3]}; *(f32x4*)(xp + 4) = (f32x4){gt[4] * y[4], gt[5] * y[5], gt[6] * y[6], gt[7] * y[7]};
                    }
            }
            return;
        }
        float ss[2][4];
#pragma unroll
        for (int ai = 0; ai < 2; ++ai)
#pragma unroll
            for (int m = 0; m < 4; ++m) ss[ai][m] = 0.f;
#pragma unroll
        for (int bj = 0; bj < 2; ++bj) {
            const int col = u.pn * 256 + bj * 128 + lc;
            float gt[8], gs[8]; { const F8 a = ld8(gate + sid * D + col); F8ARR(gt, a); }
            if (emit) { const F8 b = ld8(gsn + sid * D + col); F8ARR(gs, b); } else {
#pragma unroll
                for (int j = 0; j < 8; ++j) gs[j] = 0.f; }
#pragma unroll
            for (int ai = 0; ai < 2; ++ai)
#pragma unroll
                for (int m = 0; m < 4; ++m) {
                    const int row = u.pm * 256 + ai * 128 + wr * 64 + m * 16 + fr;
                    bf16_t* xp = xb + (size_t)row * D + col;
                    float y[8], x[8]; ACC8(y, ai, bj, m); ld8bf(xp, x);
                    float q = 0.f;
#pragma unroll
                    for (int j = 0; j < 8; ++j) { x[j] = fmaf(gt[j], y[j], x[j]); q = fmaf(x[j], x[j], q); }
                    st8bf(xp, x);
                    if (emit) {
#pragma unroll
                        for (int j = 0; j < 8; ++j) x[j] *= gs[j];
                        st8bf(xs + (size_t)row * D + col, x); }
                    ss[ai][m] += q;
                    asm volatile("" : "+v"(ss[ai][m]) :: "memory");
                }
        }
        if (emit) {
#pragma unroll
            for (int ai = 0; ai < 2; ++ai)
#pragma unroll
                for (int m = 0; m < 4; ++m) {
                    float q = ss[ai][m]; q += shfl_xor_f(q, 16); q += shfl_xor_f(q, 32);
                    const int row = u.pm * 256 + ai * 128 + wr * 64 + m * 16 + fr;
                    if (fq == 0) rowss[(size_t)row * 16 + u.pn * 4 + wc] = q; }
        }
    }
};
struct EpiNone { float* sink; __device__ __forceinline__ void operator()(EPI_ARGS) const {
    float t = 0.f;
#pragma unroll
    for (int ai = 0; ai < 2; ++ai)
#pragma unroll
        for (int bj = 0; bj < 2; ++bj)
#pragma unroll
            for (int m = 0; m < 4; ++m)
#pragma unroll
                for (int n = 0; n < 2; ++n) t += (acc[ai][bj][m][n][0] + acc[ai][bj][m][n][1]) + (acc[ai][bj][m][n][2] + acc[ai][bj][m][n][3]);
    if (t == 1.2345678e33f) sink[u.pm + wr + wc + fr + fq] = t; } };
template <int PV>
struct EpiFfT {
    const float* rowss; const float* cff; bf16_t* hid;
    __device__ __forceinline__ void operator()(EPI_ARGS) const {
        EPI_OPAQUE;
        const int sid = sid_of_pm(u.pm), lc = wc * 32 + 8 * fq;
        float c0[8], c1[8];
        if (PV == 4) {
#pragma unroll
            for (int j = 0; j < 8; ++j) { c0[j] = 0.01f * j; c1[j] = 0.02f * j; } } else { const F8 a = ld8(cff + sid * 2 * DFF + u.pn * 256 + lc), b = ld8(cff + sid * 2 * DFF + u.pn * 256 + 128 + lc); F8ARR(c0, a); F8ARR(c1, b); }
#pragma unroll
        for (int ai = 0; ai < 2; ++ai)
#pragma unroll
            for (int m = 0; m < 4; ++m) {
                const int row = u.pm * 256 + ai * 128 + wr * 64 + m * 16 + fr;
                const float rs = rowss[row];
                float g[8], uu[8]; ACC8(g, ai, 0, m); ACC8(uu, ai, 1, m);
#pragma unroll
                for (int j = 0; j < 8; ++j) { const float gg = fmaf(rs, g[j], c0[j]), uv = fmaf(rs, uu[j], c1[j]); g[j] = gg * sigm(gg) * uv; }
                if (PV != 3 || g[0] == 1.2345678e33f) st8bf(hid + (size_t)row * DFF + u.pn * 128 + lc, g);
                EPI_FENCE;
            }
    }
};

typedef EpiFfT<0> EpiFf;
template <int MAP  >
__device__ __forceinline__ int colmap(int v) {
    if (MAP == 1) { if (v >= 512 && v < 1536) { const int q = (v - 512) >> 8, r = (v - 512) & 255; return r < 128 ? 512 + 128 * q + r : 1024 + 128 * q + (r - 128); } return v; }
    if (MAP == 2) { const int q = v >> 8, r = v & 255; return r < 128 ? 128 * q + r : DFF + 128 * q + (r - 128); }
    return v;
}
template <int MAP>
__device__ __forceinline__ void gemv3_item(Ctx& C, int item, const float* W, int ldw, const LAS float* vecs, LAS float* red, const float* bias, float* out, int ostride) {
    const int vcol = item * 64 + C.lane, oc = colmap<MAP>(vcol);
    float a0 = 0.f, a1 = 0.f, a2 = 0.f;
    const int k0 = C.wave * 128;
#pragma unroll 1
    for (int kb = 0; kb < 4; ++kb) {
        float w[32];
#pragma unroll
        for (int i = 0; i < 32; ++i) w[i] = W[(size_t)(k0 + kb * 32 + i) * ldw + oc];
#pragma unroll
        for (int i = 0; i < 32; ++i) { const int k = k0 + kb * 32 + i; a0 = fmaf(vecs[k], w[i], a0); a1 = fmaf(vecs[1024 + k], w[i], a1); a2 = fmaf(vecs[2048 + k], w[i], a2); }
    }
    red[(C.wave * 3 + 0) * 64 + C.lane] = a0; red[(C.wave * 3 + 1) * 64 + C.lane] = a1; red[(C.wave * 3 + 2) * 64 + C.lane] = a2;
    __syncthreads();
    if (C.tid < 192) {
        const int s = C.tid >> 6, l = C.tid & 63; float r = 0.f;
#pragma unroll
        for (int w = 0; w < 8; ++w) r += red[(w * 3 + s) * 64 + l];
        const int vc = item * 64 + l, o2 = colmap<MAP>(vc);
        out[(size_t)s * ostride + vc] = r + (bias ? bias[o2] : 0.f);
    }
    __syncthreads();
}

template <int MAP  >
__device__ __forceinline__ int vrow_of(int n) {
    if (MAP == 1) { if (n >= 512 && n < 1024) { const int q = (n - 512) >> 7, r = (n - 512) & 127; return 512 + 256 * q + r; }
                    if (n >= 1024 && n < 1536) { const int q = (n - 1024) >> 7, r = (n - 1024) & 127; return 512 + 256 * q + 128 + r; } return n; }
    if (MAP == 2) { return n < 1024 ? 256 * (n >> 7) + (n & 127) : 256 * ((n - 1024) >> 7) + 128 + ((n - 1024) & 127); }
    if (MAP == 3) { return n < DFF ? 256 * (n >> 7) + (n & 127) : 256 * ((n - DFF) >> 7) + 128 + ((n - DFF) & 127); }
    return n;
}
template <int MAP>
__device__ __forceinline__ void transpose_item(const float* W, int K, int N, bf16_t* WT, LAS float* scr, int item, int lane) {
    const int nblk = N / 32, kb = item / nblk, nb = item % nblk, k0 = 64 * kb, n0 = 32 * nb;
    float tv[32];
#pragma unroll
    for (int i = 0; i < 32; ++i) tv[i] = W[(size_t)(k0 + 2 * i + (lane >> 5)) * N + n0 + (lane & 31)];
#pragma unroll
    for (int i = 0; i < 32; ++i) scr[(2 * i + (lane >> 5)) * 33 + (lane & 31)] = tv[i];
    asm volatile("s_waitcnt lgkmcnt(0)" ::: "memory");
    const int c = lane & 7;
#pragma unroll
    for (int j = 0; j < 4; ++j) { const int n = (lane >> 3) + 8 * j; const LAS float* s = scr + (8 * c) * 33 + n;
        u32x4 o; o.x = pk2(s[0 * 33], s[1 * 33]); o.y = pk2(s[2 * 33], s[3 * 33]); o.z = pk2(s[4 * 33], s[5 * 33]); o.w = pk2(s[6 * 33], s[7 * 33]);
        *(u32x4*)(WT + (size_t)vrow_of<MAP>(n0 + n) * K + k0 + 8 * c) = o; }
    asm volatile("s_waitcnt lgkmcnt(0)" ::: "memory");
}

__device__ __forceinline__ void phase_p0(Ctx& C) {
    REFRESH_TID(C);
    float* mod = WSP(float, WS_MOD);
    {
        LAS float* vecs = (LAS float*)C.lds; LAS float* red = vecs + 3072;
        for (int i = C.tid; i < 3072; i += 512) { const float x = i < 2048 ? C.in[1][i] : C.in[3][i - 2048]; vecs[i] = x * sigm(x); }
        __syncthreads();
        for (int it = C.bid; it < DEPTH * 96; it += C.G) {
            const int l = it / 96, item = it % 96;
            gemv3_item<0>(C, item, C.in[4] + (size_t)l * D * 6144, 6144, vecs, red, C.in[5] + (size_t)l * 6144, mod + (size_t)l * 3 * 6144, 6144);
        }
    }
    float* apow = WSP(float, WS_APOW); float* bbar = WSP(float, WS_BBAR);
    const int gt = C.bid * 512 + C.tid, GT = C.G * 512;
    for (int i = gt; i < DEPTH * 2 * NG * 65 * NP; i += GT) {
        const int p = i & 63, e = (i >> 6) % 65, ldg = (i >> 6) / 65;
        const float dt = expf(C.in[14][ldg]);
        const float lr = C.in[12][ldg * 64 + p], li = C.in[13][ldg * 64 + p];
        const float mag = expf((float)e * lr * dt); float s, c; sincos_cw((float)e * (li * dt), s, c);
        apow[(size_t)i * 2] = mag * c; apow[(size_t)i * 2 + 1] = mag * s;
    }
    for (int i = gt; i < DEPTH * 2 * NG * NP; i += GT) {
        const int ldg = i >> 6;
        const float dt = expf(C.in[14][ldg]);
        const float lr = C.in[12][i], li = C.in[13][i];
        const float mag = expf(lr * dt); float s, c; sincos_cw(li * dt, s, c);
        const float ar = mag * c, ai = mag * s, nr = ar - 1.0f, ni = ai, den = lr * lr + li * li;
        const float fr = (nr * lr + ni * li) / den, fi = (ni * lr - nr * li) / den;
        const float* br = C.in[15] + (size_t)i * 16; const float* bi = C.in[16] + (size_t)i * 16;
#pragma unroll
        for (int h = 0; h < 16; ++h) { const float x = br[h], y = bi[h]; bbar[((size_t)i * 16 + h) * 2] = fr * x - fi * y; bbar[((size_t)i * 16 + h) * 2 + 1] = fr * y + fi * x; }
    }
}

#ifndef PREP_PART
#define PREP_PART 15
#endif
__device__ __forceinline__ void phase_prep(Ctx& C, int l, int vb, int VG, int parts) {
    REFRESH_TID(C);
    if (parts & (16 | 32 | 64 | 128 | 256 | 512)) {
        LAS float* scr = (LAS float*)(C.lds + 8192 + C.wave * 8448);
        unsigned char* wt = C.ws + WS_WT + (size_t)0;
        const int gw = vb * 8 + C.wave, NGW = VG * 8;
        if (parts & 16) for (int it = gw; it < 16 * 128; it += NGW) transpose_item<1>(C.in[8] + (size_t)l * D * DIN, D, DIN, (bf16_t*)(wt + WT_IN), scr, it, C.lane);
        if (parts & 32) for (int it = gw; it < 8 * 32; it += NGW) transpose_item<0>(C.in[11] + (size_t)l * DC * D, DC, D, (bf16_t*)(wt + WT_OUTA), scr, it, C.lane);
        if (parts & 64) for (int it = gw; it < 8 * 64; it += NGW) transpose_item<2>(C.in[20] + (size_t)l * DS * 2048, DS, 2048, (bf16_t*)(wt + WT_GLU), scr, it, C.lane);
        if (parts & 128) for (int it = gw; it < 16 * 32; it += NGW) transpose_item<0>(C.in[22] + (size_t)l * D * D, D, D, (bf16_t*)(wt + WT_O), scr, it, C.lane);
        if (parts & 256) for (int it = gw; it < 16 * 176; it += NGW) transpose_item<3>(C.in[23] + (size_t)l * D * 2 * DFF, D, 2 * DFF, (bf16_t*)(wt + WT_FFIN), scr, it, C.lane);
        if (parts & 512) for (int it = gw; it < 44 * 32; it += NGW) transpose_item<0>(C.in[24] + (size_t)l * DFF * D, DFF, D, (bf16_t*)(wt + WT_FFOUT), scr, it, C.lane);
        __syncthreads();
    }
    const int gt = vb * 512 + C.tid, GT = VG * 512;
    if (parts & 1024) {
        float* gsv = WSP(float, WS_GSV); const float* modall = WSP(float, WS_MOD);
        for (int i = gt; i < DEPTH * 4 * 3 * D; i += GT) {
            const int k = i & 1023, sid = (i >> 10) % 3, w = ((i >> 10) / 3) & 3, ll = (i >> 10) / 12;
            const float* mv = modall + ((size_t)ll * 3 + sid) * 6144;
            float r;
            if (w == 0) r = C.in[6][ll * D + k] * (1.0f + mv[1024 + k]);
            else if (w == 1) r = C.in[7][ll * D + k] * (1.0f + mv[4096 + k]);
            else if (w == 2) r = mv[2048 + k];
            else r = mv[5120 + k];
            gsv[i] = r;
        }
    }
    const float* apow = WSP(float, WS_APOW) + (size_t)l * 2 * NG * 65 * NP * 2;
    const float* bbar = WSP(float, WS_BBAR) + (size_t)l * 2 * NG * NP * 16 * 2;
    const float* cre = C.in[17] + (size_t)l * 2 * NG * 16 * NP; const float* cim = C.in[18] + (size_t)l * 2 * NG * 16 * NP;
    if (parts & 4) {
        bf16_t* kc = WSP(bf16_t, WS_KC + (size_t)0);
        LAS float* Es = (LAS float*)C.lds;
        LAS float* Cs = Es + 2 * 4 * 16 * 132;
        for (int it = vb; it < NG * 16; it += VG) {
            const int g = it >> 4, eg = it & 15;
#pragma unroll 4
            for (int i = 0; i < 16; ++i) {
                const int idx = C.tid + 512 * i, p = idx & 63, hi = (idx >> 6) & 15, e4 = (idx >> 10) & 3, dir = idx >> 12, e = eg * 4 + e4;
                const float* ap = apow + (((size_t)(dir * NG + g) * 65 + e) * NP + p) * 2; const float* bb = bbar + ((size_t)(dir * NG + g) * NP + p) * 32 + hi * 2;
                const float pr = ap[0], pi = ap[1], br = bb[0], bi = bb[1];
                Es[((dir * 4 + e4) * 16 + hi) * 132 + p * 2] = pr * br - pi * bi; Es[((dir * 4 + e4) * 16 + hi) * 132 + p * 2 + 1] = pr * bi + pi * br;
            }
#pragma unroll
            for (int i = 0; i < 4; ++i) {
                const int idx = C.tid + 512 * i, p = idx & 63, ho = (idx >> 6) & 15, dir = idx >> 10;
                Cs[(dir * 16 + ho) * 132 + p * 2] = cre[((size_t)(dir * NG + g) * 16 + ho) * NP + p]; Cs[(dir * 16 + ho) * 132 + p * 2 + 1] = cim[((size_t)(dir * NG + g) * 16 + ho) * NP + p];
            }
            __syncthreads();
#pragma unroll 1
            for (int i = 0; i < 4; ++i) {
                const int o = C.tid + 512 * i, hi = o & 15, ho = (o >> 4) & 15, e4 = (o >> 8) & 3, dir = o >> 10, e = eg * 4 + e4;
                float val = 0.f;
                const int nd = (e == 0 && dir == 0) ? 2 : 1;
                for (int dd2 = 0; dd2 < nd; ++dd2) {
                    const int d2 = dir + dd2;
                    const LAS f32x4* er = (const LAS f32x4*)(Es + ((d2 * 4 + e4) * 16 + hi) * 132); const LAS f32x4* cr4 = (const LAS f32x4*)(Cs + (d2 * 16 + ho) * 132);
#pragma unroll 8
                    for (int q = 0; q < 32; ++q) { const f32x4 ev = er[q], cv = cr4[q]; val += (cv[0] * ev[0] - cv[1] * ev[1]) + (cv[2] * ev[2] - cv[3] * ev[3]); }
                }
                if (!(e == 0 && dir == 1)) { const int dd = dir ? 63 - e : 63 + e; kc[((size_t)g * 127 + dd) * 256 + ho * 16 + hi] = (bf16_t)f2bf(val); }
            }
            __syncthreads();
        }
    }
    if (parts & 8) {
        bf16_t* wg = WSP(bf16_t, WS_WG + (size_t)0);
#pragma unroll 2
        for (int i = gt; i < NG * 256 * 64; i += GT) {
            const int j = i & 63, n = (i >> 6) & 255, g = i >> 14, dir = n >> 7, ri = (n >> 6) & 1, p = n & 63, e = dir ? j : 63 - j;
            const float* ap = apow + (((size_t)(dir * NG + g) * 65 + e) * NP + p) * 2; const float pr = ap[0], pi = ap[1];
            const float* bb = bbar + ((size_t)(dir * NG + g) * NP + p) * 32;
            float o[16];
#pragma unroll
            for (int h = 0; h < 16; ++h) { const float br = bb[h * 2], bi = bb[h * 2 + 1]; o[h] = ri ? (pr * bi + pi * br) : (pr * br - pi * bi); }
            u32x4 w0, w1; w0.x = pk2(o[0], o[1]); w0.y = pk2(o[2], o[3]); w0.z = pk2(o[4], o[5]); w0.w = pk2(o[6], o[7]);
            w1.x = pk2(o[8], o[9]); w1.y = pk2(o[10], o[11]); w1.z = pk2(o[12], o[13]); w1.w = pk2(o[14], o[15]);
            u32x4* dst = (u32x4*)(wg + ((size_t)g * 256 + n) * 1024 + j * 16); dst[0] = w0; dst[1] = w1;
        }
    }
    if (parts & 8) {
        bf16_t* mg = WSP(bf16_t, WS_MG + (size_t)0);
#pragma unroll 4
        for (int i = gt; i < NG * 1024 * 32; i += GT) {
            const int kc8 = i & 31, n = (i >> 5) & 1023, g = i >> 15, t = n >> 4, ho = n & 15, k0 = kc8 * 8, dir = k0 >> 7, ri = (k0 >> 6) & 1, p0 = k0 & 63, e = dir ? 64 - t : t + 1;
            const f32x4* ap4 = (const f32x4*)(apow + (((size_t)(dir * NG + g) * 65 + e) * NP + p0) * 2);
            const f32x4* cr4 = (const f32x4*)(cre + ((size_t)(dir * NG + g) * 16 + ho) * NP + p0); const f32x4* ci4 = (const f32x4*)(cim + ((size_t)(dir * NG + g) * 16 + ho) * NP + p0);
            const f32x4 a0 = ap4[0], a1 = ap4[1], a2 = ap4[2], a3 = ap4[3], c0 = cr4[0], c1 = cr4[1], d0 = ci4[0], d1 = ci4[1];
            const float prs[8] = {a0[0], a0[2], a1[0], a1[2], a2[0], a2[2], a3[0], a3[2]}, pis[8] = {a0[1], a0[3], a1[1], a1[3], a2[1], a2[3], a3[1], a3[3]};
            const float crs[8] = {c0[0], c0[1], c0[2], c0[3], c1[0], c1[1], c1[2], c1[3]}, cis[8] = {d0[0], d0[1], d0[2], d0[3], d1[0], d1[1], d1[2], d1[3]};
            float o[8];
#pragma unroll
            for (int q = 0; q < 8; ++q) o[q] = ri ? -(crs[q] * pis[q] + cis[q] * prs[q]) : (crs[q] * prs[q] - cis[q] * pis[q]);
            st8bf(mg + ((size_t)g * 1024 + n) * 256 + k0, o);
        }
    }
    if (parts & 1024) {
        const float* modall = WSP(float, WS_MOD);
        const int gw = vb * 8 + C.wave, NGW = VG * 8;
        for (int row = gw; row < TR; row += NGW) {
            const int sid = sid_of_row(row);
            const float* src = row < NLAT ? C.in[0] + (size_t)row * D : C.in[2] + (size_t)(row - NLAT) * D;
            bf16_t* xs = WSP(bf16_t, WS_XS) + (size_t)row * D;
            float q = 0.f;
#pragma unroll
            for (int j = 0; j < 4; ++j) {
                const int k = j * 256 + C.lane * 4;
                const f32x4 x = *(const f32x4*)(src + k), ng = *(const f32x4*)(C.in[6] + k), sc = *(const f32x4*)(modall + (size_t)sid * 6144 + 1024 + k);
                if (row >= NLAT) *(f32x4*)(WSP(float, WS_CTXX) + (size_t)(row - NLAT) * D + k) = x;
                else *(unsigned long long*)(WSP(bf16_t, WS_XB) + (size_t)row * D + k) = (unsigned long long)pk2(x[0], x[1]) | ((unsigned long long)pk2(x[2], x[3]) << 32);
                q += (x[0] * x[0] + x[1] * x[1]) + (x[2] * x[2] + x[3] * x[3]);
                const unsigned w0 = pk2(x[0] * ng[0] * (1.f + sc[0]), x[1] * ng[1] * (1.f + sc[1])), w1 = pk2(x[2] * ng[2] * (1.f + sc[2]), x[3] * ng[3] * (1.f + sc[3]));
                *(unsigned long long*)(xs + k) = (unsigned long long)w0 | ((unsigned long long)w1 << 32);
            }
            q = wave_sum(q);
            if (C.lane < 16) WSP(float, WS_ROWSS)[(size_t)row * 16 + C.lane] = C.lane == 0 ? q : 0.f;
        }
    }
}

__device__ __forceinline__ void phase_rstd(Ctx& C, int nrows) {
    REFRESH_TID(C);
    for (int row = C.bid * 512 + C.tid; row < nrows; row += C.G * 512) WSP(float, WS_RSTD)[row] = rstd_of(WSP(float, WS_ROWSS), row);
}

__device__ __forceinline__ void ctx_finalize(Ctx& C, const float* gs, const float* slab) {
    REFRESH_TID(C);
    const int gw = C.bid * 8 + C.wave, NGW = C.G * 8;
    for (int r = gw; r < NCTX; r += NGW) {
        float* src = WSP(float, WS_CTXX) + (size_t)r * D; bf16_t* xs = WSP(bf16_t, WS_XS) + (size_t)(NLAT + r) * D; float q = 0.f;
#pragma unroll
        for (int j = 0; j < 4; ++j) {
            const int k = j * 256 + C.lane * 4;
            f32x4 x = *(const f32x4*)(src + k); const f32x4 g = *(const f32x4*)(gs + k);
#pragma unroll
            for (int sp = 0; sp < 4; ++sp) x += *(const f32x4*)(slab + ((size_t)sp * NCTX + r) * D + k);
            *(f32x4*)(src + k) = x;
            q += (x[0] * x[0] + x[1] * x[1]) + (x[2] * x[2] + x[3] * x[3]);
            const unsigned w0 = pk2(x[0] * g[0], x[1] * g[1]), w1 = pk2(x[2] * g[2], x[3] * g[3]);
            *(unsigned long long*)(xs + k) = (unsigned long long)w0 | ((unsigned long long)w1 << 32);
        }
        q = wave_sum(q);
        if (C.lane < 16) WSP(float, WS_ROWSS)[(size_t)(NLAT + r) * 16 + C.lane] = C.lane == 0 ? q : 0.f;
        if (C.lane == 0) WSP(float, WS_RSTD)[NLAT + r] = rsqrtf(q * (1.0f / 1024.0f) + RMS_EPS);
    }
}

__device__ __forceinline__ void phase_prep_b(Ctx& C, int l, int wsel) {
    REFRESH_TID(C);
    const float* mod = WSP(float, WS_MOD) + (size_t)l * 3 * 6144;
    const int gw = C.bid * 8 + C.wave, NGW = C.G * 8;
    if (wsel == 0) { if (l > 0) ctx_finalize(C, WSP(float, WS_GSV) + ((size_t)l * 4 + 0) * 3 * D + 2 * D, WSP(float, WS_YB));
        phase_rstd(C, l > 0 ? NLAT : TR); REFRESH_TID(C); }
    {
        const int which = wsel;
        const int NV = which ? 2 * DFF : DIN;
        const bf16_t* wt = (const bf16_t*)(C.ws + WS_WT + (size_t)0 + (which ? WT_FFIN : WT_IN));
        const float* shb = mod + (which ? 3072 : 0);
        float sh[3][16];
#pragma unroll
        for (int sdx = 0; sdx < 3; ++sdx)
#pragma unroll
            for (int j = 0; j < 2; ++j) { const F8 a = ld8(shb + (size_t)sdx * 6144 + j * 512 + C.lane * 8); F8ARR((&sh[sdx][j * 8]), a); }
        float* out = which ? WSP(float, WS_CFF) : WSP(float, WS_CIN);
        for (int v = gw; v < NV; v += NGW) {
            float w0[8], w1[8]; ld8bf(wt + (size_t)v * D + C.lane * 8, w0); ld8bf(wt + (size_t)v * D + 512 + C.lane * 8, w1);
            float r0 = 0.f, r1 = 0.f, r2 = 0.f;
#pragma unroll
            for (int j = 0; j < 8; ++j) { r0 += sh[0][j] * w0[j] + sh[0][8 + j] * w1[j]; r1 += sh[1][j] * w0[j] + sh[1][8 + j] * w1[j]; r2 += sh[2][j] * w0[j] + sh[2][8 + j] * w1[j]; }
            r0 = wave_sum(r0); r1 = wave_sum(r1); r2 = wave_sum(r2);
            if (C.lane == 0) {
                const float bb = which ? 0.f : C.in[9][(size_t)l * DIN + colmap<1>(v)];
                out[v] = r0 + bb; out[NV + v] = r1 + bb; out[2 * NV + v] = r2 + bb; }
        }
    }
}

__device__ __forceinline__ void phase_conv(Ctx& C, int l, int vb, int VG) {
    REFRESH_TID(C);
    const float* cw = C.in[10] + (size_t)l * 3 * DC;
    bf16_t* gb = WSP(bf16_t, WS_GB); const bf16_t* v = WSP(bf16_t, WS_V);
    const int gt = vb * 512 + C.tid, GT = VG * 512;
    for (int i = gt; i < TR * 64; i += GT) {
        const int row = i >> 6, c8 = (i & 63) * 8;
        const bool lat = row < NLAT; const int pos = lat ? (row & 63) : ((row - NLAT) & 255), lastp = lat ? 63 : 255;
        float a[8], b[8], c[8], g[8], w0[8], w1[8], w2[8];
        ld8bf(v + (size_t)row * DC + c8, b);
        if (pos > 0) ld8bf(v + (size_t)(row - 1) * DC + c8, a); else {
#pragma unroll
            for (int j = 0; j < 8; ++j) a[j] = 0.f; }
        if (pos < lastp) ld8bf(v + (size_t)(row + 1) * DC + c8, c); else {
#pragma unroll
            for (int j = 0; j < 8; ++j) c[j] = 0.f; }
        ld8bf(gb + (size_t)row * DC + c8, g);
        { const F8 x = ld8(cw + c8), y = ld8(cw + DC + c8), z = ld8(cw + 2 * DC + c8); F8ARR(w0, x); F8ARR(w1, y); F8ARR(w2, z); }
#pragma unroll
        for (int j = 0; j < 8; ++j) g[j] *= (w0[j] * a[j] + w1[j] * b[j] + w2[j] * c[j]);
        st8bf(gb + (size_t)row * DC + c8, g);
    }
}

__device__ __forceinline__ void phase_scan(Ctx& C, int l) {
    REFRESH_TID(C);
    LAS float* ag = (LAS float*)C.lds;
    for (int blk = C.bid; blk < 256; blk += C.G) {
        const int ci = blk * 32 + (C.tid & 31), seg = C.tid >> 5;
        const int p = ci & 63, g = (ci >> 6) & 31, dir = (ci >> 11) & 1, b = ci >> 12;
        const float* ap = WSP(float, WS_APOW) + ((((size_t)(l * 2 + dir) * NG + g) * 65 + 64) * NP + p) * 2;
        const float ar = ap[0], ai = ap[1];
        const float* sl = WSP(float, WS_SLOC) + (size_t)g * NCHP * 256 + dir * 128 + p;
        bf16_t* so = WSP(bf16_t, WS_SIN) + (size_t)g * NCHP * 256 + dir * 128 + p;
        float lr[16], li[16];
#pragma unroll
        for (int k = 0; k < 16; ++k) { const int kk = seg * 16 + k, ch = dir ? 256 * b + 255 - kk : 256 * b + kk; lr[k] = sl[(size_t)ch * 256] + sl[SLOC_HALF / 4 + (size_t)ch * 256]; li[k] = sl[(size_t)ch * 256 + 64] + sl[SLOC_HALF / 4 + (size_t)ch * 256 + 64]; }
        float xr = 0.f, xi = 0.f;
#pragma unroll
        for (int k = 0; k < 16; ++k) { const float nr = ar * xr - ai * xi + lr[k], ni = ar * xi + ai * xr + li[k]; xr = nr; xi = ni; }
        ag[((seg + 1) * 32 + (C.tid & 31)) * 2] = xr; ag[((seg + 1) * 32 + (C.tid & 31)) * 2 + 1] = xi;
        if (seg == 0) {
            float sr = 0.f, si = 0.f;
#pragma unroll
            for (int st = 0; st < 4; ++st) {
                const int ch = dir ? 512 + 4 * b + 3 - st : 512 + 4 * b + st;
                so[(size_t)ch * 256] = (bf16_t)f2bf(sr); so[(size_t)ch * 256 + 64] = (bf16_t)f2bf(si);
                const float cr = sl[(size_t)ch * 256] + sl[SLOC_HALF / 4 + (size_t)ch * 256], cim = sl[(size_t)ch * 256 + 64] + sl[SLOC_HALF / 4 + (size_t)ch * 256 + 64];
                const float nr = ar * sr - ai * si + cr, ni = ar * si + ai * sr + cim; sr = nr; si = ni;
            }
            ag[(C.tid & 31) * 2] = sr; ag[(C.tid & 31) * 2 + 1] = si;
        }
        __syncthreads();
        float a16r = ar, a16i = ai;
#pragma unroll
        for (int q = 0; q < 4; ++q) { const float nr = a16r * a16r - a16i * a16i, ni = 2.f * a16r * a16i; a16r = nr; a16i = ni; }
        float sr = ag[(C.tid & 31) * 2], si = ag[(C.tid & 31) * 2 + 1];
        for (int s2 = 0; s2 < seg; ++s2) {
            const float gr = ag[((s2 + 1) * 32 + (C.tid & 31)) * 2], gi = ag[((s2 + 1) * 32 + (C.tid & 31)) * 2 + 1];
            const float nr = a16r * sr - a16i * si + gr, ni = a16r * si + a16i * sr + gi; sr = nr; si = ni;
        }
#pragma unroll
        for (int k = 0; k < 16; ++k) {
            const int kk = seg * 16 + k, ch = dir ? 256 * b + 255 - kk : 256 * b + kk;
            so[(size_t)ch * 256] = (bf16_t)f2bf(sr); so[(size_t)ch * 256 + 64] = (bf16_t)f2bf(si);
            const float nr = ar * sr - ai * si + lr[k], ni = ar * si + ai * sr + li[k]; sr = nr; si = ni;
        }
        __syncthreads();
    }
}

__device__ __forceinline__ void phase_final(Ctx& C) {
    REFRESH_TID(C);
    const int gw = C.bid * 8 + C.wave, NGW = C.G * 8;
    const float* fg = C.in[25];
    for (int row = gw; row < NLAT; row += NGW) {
        float* xr = C.out + (size_t)row * D; const bf16_t* xbr = WSP(bf16_t, WS_XB) + (size_t)row * D; f32x4 x[4]; float q = 0.f;
#pragma unroll
        for (int j = 0; j < 4; ++j) { const unsigned long long w = *(const unsigned long long*)(xbr + j * 256 + C.lane * 4); const unsigned w0 = (unsigned)w, w1 = (unsigned)(w >> 32);
            x[j] = (f32x4){bflo(w0), bfhi(w0), bflo(w1), bfhi(w1)}; q += (x[j][0] * x[j][0] + x[j][1] * x[j][1]) + (x[j][2] * x[j][2] + x[j][3] * x[j][3]); }
        q = wave_sum(q); const float rs = rsqrtf(q * (1.0f / 1024.0f) + RMS_EPS);
#pragma unroll
        for (int j = 0; j < 4; ++j) { const f32x4 g = *(const f32x4*)(fg + j * 256 + C.lane * 4); *(f32x4*)(xr + j * 256 + C.lane * 4) = x[j] * rs * g; }
    }
}

template <class Epi>
__device__ __forceinline__ void gemm_plain(Ctx& C, const bf16_t* A, const bf16_t* Bt, int M, int N, int K, const Epi& E, int mode = 0, int kstride = 128) {
    pg8::Seg s; s.A = (const char*)A; s.B = (const char*)Bt; s.tA = 256 * K * 2; s.tB = 256 * K * 2; s.gA = 0; s.gB = 0; s.hA = 128 * K * 2; s.hB = 128 * K * 2; s.kA = kstride; s.kB = kstride;
    const pg8::Voff v = pg8::voff_plain(C.wave * 64 + lane_id_v(), K * 2, K * 2);
    pg8::Order S; S.init(M / 256, N / 256, 1, C.G, C.bid, K / 64, mode);
    pg8::gemm_phase<Epi, false>(C.lds, s, s, K / 64, v, v, S, E, C.wave * 64 + lane_id_v());
}

constexpr int PH_PER_LAYER = 12, N_PHASES = 1 + DEPTH * PH_PER_LAYER + 1;

__global__ void __launch_bounds__(512, 2) mega(Args args) {
    extern __shared__ __attribute__((aligned(16))) unsigned char lds_raw[];
    Ctx C;
    C.in = args.in; C.out = args.out; C.ws = args.ws; C.lds = (LAS unsigned char*)lds_raw;
    C.G = gridDim.x; C.bid = blockIdx.x;
    const int wave0_ = __builtin_amdgcn_readfirstlane(threadIdx.x >> 6);
    volatile LAS unsigned* bst_ = (volatile LAS unsigned*)(C.lds + LDS_BYTES - 16);
    if (threadIdx.x == 0) { bst_[0] = 0u; bst_[1] = 0u; }
    __syncthreads();
    XcdBarrier xbar; xbar.bar = (unsigned*)(args.ws + WS_BAR); xbar.x = 0; xbar.st = bst_;
    if (args.coop) xbar = xcd_barrier_post((unsigned*)(args.ws + WS_BAR), bst_, (int)threadIdx.x);

#if PROBE_CLK
    const long long pc0_ = clock64(), pw0_ = wall_clock64();
#endif
    long long tacc_ = 0;
    for (int ph = args.ph_lo; ph < args.ph_hi; ++ph) {
      const long long tph0_ = PROBE_TMASK ? wall_clock64() : 0;
      const int nrep_ = (PROBE_SP == -1 ? (ph == 0) : (PROBE_SP >= 0 && ph >= 1 && ph < N_PHASES - 1 && (ph - 1) % PH_PER_LAYER == PROBE_SP)) ? 1 + PROBE_REP : 1;
      for (int rep_ = 0; rep_ < nrep_; ++rep_) {
        if (rep_ > 0 && args.coop) xcd_barrier(xbar, wave0_ * 64 + lane_id_v());
        C.wave = wave0_; C.tid = 0; C.lane = 0;
        if (ph == 0) phase_p0(C);
        else if (ph == N_PHASES - 1) phase_final(C);
        else {
            const int l = (ph - 1) / PH_PER_LAYER, sp = (ph - 1) % PH_PER_LAYER;
            unsigned char* wt = C.ws + WS_WT + (size_t)0;
            const int MR = (l == DEPTH - 1) ? NLAT : TR;
            switch ((ONLY_SP >= 0) ? ONLY_SP : sp) {
            case 0: if (l == 0) phase_prep(C, 0, C.bid, C.G, 4 | 8 | 16 | 32 | 64 | 128 | 1024); break;
            case 1: phase_prep_b(C, l, 0); break;
            case 2: {
                EpiIn E{WSP(float, WS_RSTD), WSP(float, WS_CIN), WSP(bf16_t, WS_GB), WSP(bf16_t, WS_V), WSP(bf16_t, WS_U), WSP(bf16_t, WS_SGA), WSP(bf16_t, WS_YB)};
                gemm_plain(C, WSP(bf16_t, WS_XS), (const bf16_t*)(wt + WT_IN), TR, DIN, D, E);
                if (rep_ == 0 && C.bid >= 32) phase_prep(C, l, C.bid - 32, C.G - 32, 256 | 512);
            } break;
            case 3: {
                pg8::Seg s; s.A = (const char*)WSP(bf16_t, WS_U); s.B = (const char*)WSP(bf16_t, WS_WG + (size_t)0);
                s.tA = 256 * 1024 * 2; s.gA = UROWS * 16 * 2; s.hA = 128 * 1024 * 2; s.kA = 128;
                s.tB = 0; s.gB = 256 * 1024 * 2; s.hB = 128 * 1024 * 2; s.kB = 128;
                const pg8::Voff v = pg8::voff_plain(C.wave * 64 + lane_id_v(), 2048, 2048);
                pg8::Order S; S.init(3, 1, NG, C.G, C.bid, 16, 2);
                EpiSloc E{WSP(float, WS_SLOC)};
                pg8::gemm_phase<EpiSloc, false>(C.lds, s, s, 16, v, v, S, E, C.wave * 64 + lane_id_v());
                if (rep_ == 0 && l == DEPTH - 1) phase_conv(C, l, C.bid, C.G);
            } break;
            case 4: phase_scan(C, l); break;
            case 5: {
                pg8::Seg s0, s1;
                s0.A = (const char*)WSP(bf16_t, WS_U); s0.tA = 256 * 1024 * 2; s0.gA = UROWS * 16 * 2; s0.hA = 128 * 1024 * 2; s0.kA = 128;
                s0.B = (const char*)WSP(bf16_t, WS_KC + (size_t)0) + 2 * 63 * 256 - 1536; s0.tB = 8192; s0.gB = 127 * 256 * 2; s0.hB = 4096; s0.kB = -2048;
                s1.A = (const char*)WSP(bf16_t, WS_SIN); s1.tA = 256 * 256 * 2; s1.gA = NCHP * 256 * 2; s1.hA = 128 * 256 * 2; s1.kA = 128;
                s1.B = (const char*)WSP(bf16_t, WS_MG + (size_t)0); s1.tB = 256 * 256 * 2; s1.gB = 1024 * 256 * 2; s1.hB = 128 * 256 * 2; s1.kB = 128;
                const int tid3_ = C.wave * 64 + lane_id_v();
                pg8::Voff v0 = pg8::voff_plain(tid3_, 2048, 32), v1 = pg8::voff_plain(tid3_, 512, 512);
                {
                    int R, Cc; pg8::stage_rc(tid3_ * 16, R, Cc); int Rb = (R & ~31) + pg8::perm32(R & 31);
                    v0.b0 = (unsigned)(Rb * 32 - (Cc >> 4) * 512 + (Cc & 15) * 2 + 1536);
                    pg8::stage_rc(tid3_ * 16 + 8192, R, Cc); Rb = (R & ~31) + pg8::perm32(R & 31);
                    v0.b1 = (unsigned)(Rb * 32 - (Cc >> 4) * 512 + (Cc & 15) * 2 + 1536);
                }
                pg8::Order S; S.init(l == DEPTH - 1 ? 2 : 3, 4, NG, C.G, C.bid, 20);
                EpiSsm E{WSP(bf16_t, WS_U), C.in[19] + (size_t)l * DS, WSP(bf16_t, WS_S)};
                pg8::gemm_phase<EpiSsm, true>(C.lds, s0, s1, 16, v0, v1, S, E, C.wave * 64 + lane_id_v());
                if (rep_ == 0 && l < DEPTH - 1 && C.bid >= 128) phase_conv(C, l, C.bid - 128, C.G - 128);
            } break;
            case 6: {
                EpiGlu E{C.in[21] + (size_t)l * 2048, WSP(bf16_t, WS_YB)};
                gemm_plain(C, WSP(bf16_t, WS_S), (const bf16_t*)(wt + WT_GLU), MR, 2048, DS, E);
            } break;
            case 7: {
                EpiMerge E{WSP(bf16_t, WS_SGA), WSP(bf16_t, WS_YB)};
                gemm_plain(C, WSP(bf16_t, WS_GB), (const bf16_t*)(wt + WT_OUTA), MR, D, DC, E);
            } break;
            case 8: {
                const float* gsv = WSP(float, WS_GSV) + (size_t)l * 4 * 3 * D;
                EpiRes<1, 1> E{WSP(bf16_t, WS_XB), WSP(float, WS_V), gsv + 2 * 3 * D, gsv + 1 * 3 * D, WSP(bf16_t, WS_XS), WSP(float, WS_ROWSS)};
                gemm_plain(C, WSP(bf16_t, WS_YB), (const bf16_t*)(wt + WT_O), NLAT, D, D, E, l + 1 < DEPTH ? 3 : 0);
                if (l + 1 < DEPTH && C.bid >= 32) phase_prep(C, l + 1, C.bid - 32, C.G - 32, 4 | 8);
            } break;
            case 9: phase_prep_b(C, l, 1); phase_rstd(C, NLAT); if (l + 1 < DEPTH) ctx_finalize(C, WSP(float, WS_GSV) + ((size_t)l * 4 + 1) * 3 * D + 2 * D, WSP(float, WS_V)); break;
            case 10: {
#if PROBE_EMPTY
                if (rep_ > 0 && PROBE_EMPTY <= 2) { EpiNone E0{WSP(float, WS_CIN)}; gemm_plain(C, WSP(bf16_t, WS_XS), (const bf16_t*)(wt + WT_FFIN), MR, 2 * DFF, D, E0, 0, PROBE_EMPTY == 2 ? 0 : 128); break; }
                if (rep_ > 0 && PROBE_EMPTY >= 3) { EpiFfT<PROBE_EMPTY> E0{WSP(float, WS_RSTD), WSP(float, WS_CFF), WSP(bf16_t, WS_HID)}; gemm_plain(C, WSP(bf16_t, WS_XS), (const bf16_t*)(wt + WT_FFIN), MR, 2 * DFF, D, E0); break; }
#endif
                EpiFf E{WSP(float, WS_RSTD), WSP(float, WS_CFF), WSP(bf16_t, WS_HID)};
                gemm_plain(C, WSP(bf16_t, WS_XS), (const bf16_t*)(wt + WT_FFIN), MR, 2 * DFF, D, E);
                if (rep_ == 0 && l + 1 < DEPTH && C.bid >= 44) phase_prep(C, l + 1, C.bid - 44, C.G - 44, 16 | 32 | 64 | 128);
            } break;
            case 11: {
                const int ln = l + 1 < DEPTH ? l + 1 : l;
                const float* gsv = WSP(float, WS_GSV);
                if (l + 1 < DEPTH) {
                    EpiRes<1, 1> E{WSP(bf16_t, WS_XB), WSP(float, WS_YB), gsv + ((size_t)l * 4 + 3) * 3 * D, gsv + ((size_t)ln * 4 + 0) * 3 * D, WSP(bf16_t, WS_XS), WSP(float, WS_ROWSS)};
                    gemm_plain(C, WSP(bf16_t, WS_HID), (const bf16_t*)(wt + WT_FFOUT), NLAT, D, DFF, E, 3);
                } else {
                    EpiRes<0, 0> E{WSP(bf16_t, WS_XB), WSP(float, WS_YB), gsv + ((size_t)l * 4 + 3) * 3 * D, gsv + ((size_t)ln * 4 + 0) * 3 * D, WSP(bf16_t, WS_XS), WSP(float, WS_ROWSS)};
                    gemm_plain(C, WSP(bf16_t, WS_HID), (const bf16_t*)(wt + WT_FFOUT), NLAT, D, DFF, E, 0);
                }
            } break;
            }
        }
      }
        const bool empty_ph_ = (ph >= 1 + PH_PER_LAYER && ph < N_PHASES - 1 && (ph - 1) % PH_PER_LAYER == 0);
        if (ph + 1 < args.ph_hi && args.coop && !empty_ph_) {
            if (ph + 2 == args.ph_hi) cg::this_grid().sync();
            else xcd_barrier(xbar, wave0_ * 64 + lane_id_v());
        }
        if (PROBE_TMASK) { const int spx_ = ph == 0 ? 12 : (ph == N_PHASES - 1 ? 13 : (ph - 1) % PH_PER_LAYER); if ((PROBE_TMASK >> spx_) & 1) tacc_ += wall_clock64() - tph0_; }
    }
#if PROBE_TMASK
    if (blockIdx.x == 0 && threadIdx.x == 0) { const long long w1_ = wall_clock64(); while (wall_clock64() - w1_ < tacc_) __builtin_amdgcn_s_sleep(8); }
#endif
#if PROBE_CLK
    if (blockIdx.x == 0 && threadIdx.x == 0) { const long long pc1_ = clock64(), pw1_ = wall_clock64(); const long long mhz = (pc1_ - pc0_) * 100 / (pw1_ - pw0_); const long long extra_us = (mhz - 1000) * 2; if (extra_us > 0 && extra_us < 5000) { while (wall_clock64() - pw1_ < extra_us * 100) __builtin_amdgcn_s_sleep(8); } }
#endif
}

extern "C" void kernel_launch(void* const* d_in, const int* in_sizes, int n_in, void* d_out, int out_size, void* d_ws, size_t ws_size, hipStream_t stream) {
    static int grid = 0;
    if (grid == 0) {
        if (n_in != 26 || out_size != NLAT * D || ws_size < WS_END) { fprintf(stderr, "kernel_launch: unexpected shapes (n_in %d out %d ws %zu need %zu)\n", n_in, out_size, ws_size, (size_t)WS_END); grid = -1; return; }
        if (hipFuncSetAttribute((const void*)mega, hipFuncAttributeMaxDynamicSharedMemorySize, LDS_BYTES) != hipSuccess) { fprintf(stderr, "hipFuncSetAttribute failed\n"); grid = -1; return; }
        int dev = 0, cus = 0, per_cu = 0;
        hipGetDevice(&dev); hipDeviceGetAttribute(&cus, hipDeviceAttributeMultiprocessorCount, dev);
        hipOccupancyMaxActiveBlocksPerMultiprocessor(&per_cu, (const void*)mega, 512, LDS_BYTES);
        (void)hipGetLastError();
        if (per_cu < 1) fprintf(stderr, "occupancy query says %d blocks per CU\n", per_cu);
        grid = cus > 0 ? cus : 256;
    }
    if (grid < 0) return;
    Args a{};
    for (int i = 0; i < 26; ++i) a.in[i] = (const float*)d_in[i];
    a.out = (float*)d_out; a.ws = (unsigned char*)d_ws; a.pad = 0;
#if MK_COOP
    if (hipMemsetAsync((char*)d_ws + WS_BAR, 0, 16384, stream) != hipSuccess) { fprintf(stderr, "memset failed\n"); return; }
    a.ph_lo = 0; a.ph_hi = N_PHASES; a.coop = 1;
    void* kargs[] = {&a};
    hipError_t e = hipLaunchCooperativeKernel((const void*)mega, dim3(grid), dim3(512), kargs, LDS_BYTES, stream);
    if (e != hipSuccess) fprintf(stderr, "cooperative launch failed: %s (grid %d)\n", hipGetErrorString(e), grid);
#else
    for (int ph = 0; ph < N_PHASES; ++ph) {
        a.ph_lo = ph; a.ph_hi = ph + 1; a.coop = 0;
        hipLaunchKernelGGL(mega, dim3(grid), dim3(512), LDS_BYTES, stream, a);
    }
#endif
}
```
